# Optimizing an MI355X kernel written in HIP

```python
import jax, jax.numpy as jnp
from jax import lax
import numpy as np

D_MODEL = 1024
BATCH = 16
SEQ = 4096
DEPTH = 1
DEC_BATCH = 16
DEC_SEQ = 32
PAST_LEN = 2048

CHUNK = 64
N_META = 16
D_FF = 2816
D_CONV = 1024
CONV_WIDTH = 3
N_HEADS = 16
QK_NOPE = 64
QK_ROPE = 32
QK_DIM = QK_NOPE + QK_ROPE
V_HEAD = 64
Q_LORA = 384
KV_LORA = 128
ROPE_THETA = 10000.0
RMS_EPS = 1e-6
Q_BLOCK = 128
NEG_INF = -1e30
COL_SIZES = (D_CONV, D_CONV, D_CONV, Q_LORA, KV_LORA, QK_ROPE, D_MODEL, D_MODEL)
D_IN_ALL = sum(COL_SIZES)

kernel_name = "hybrid_shortconv_mla_macaron_stream_step"


def rms_norm(x, g):
    xf = x.astype(jnp.float32)
    y = xf * lax.rsqrt(jnp.mean(xf * xf, axis=-1, keepdims=True) + RMS_EPS)
    return (y * g.astype(jnp.float32)).astype(x.dtype)


def half_step_ffn(x, g, w_gate, w_up, w_down):
    h = rms_norm(x, g)
    return x + 0.5 * ((jax.nn.silu(h @ w_gate) * (h @ w_up)) @ w_down)


def rotary(x, pos):
    half = QK_ROPE // 2
    inv_freq = ROPE_THETA ** (-jnp.arange(half, dtype=jnp.float32) / half)
    ang = pos.astype(jnp.float32)[:, None] * inv_freq[None, :]
    cos = jnp.cos(ang)[None, :, None, :]
    sin = jnp.sin(ang)[None, :, None, :]
    xf = x.astype(jnp.float32)
    x1, x2 = xf[..., :half], xf[..., half:]
    return jnp.concatenate([x1 * cos - x2 * sin, x2 * cos + x1 * sin], axis=-1).astype(x.dtype)


def split_columns(z):
    offsets = [int(o) for o in np.cumsum(COL_SIZES)[:-1]]
    return jnp.split(z, offsets, axis=-1)


def project_inputs(h, pos, w_in_all, q_a_norm, w_uq, kv_a_norm, q_norm):
    bsz, L, _ = h.shape
    b_gate, c_gate, v_conv, q_lat, kv_lat, k_pe, g_conv, g_mla = split_columns(h @ w_in_all)
    conv_in = c_gate * v_conv
    q = (rms_norm(q_lat, q_a_norm) @ w_uq).reshape(bsz, L, N_HEADS, QK_DIM)
    q = jnp.concatenate([q[..., :QK_NOPE], rotary(q[..., QK_NOPE:], pos)], axis=-1)
    q = rms_norm(q, q_norm)
    c_kv = rms_norm(kv_lat, kv_a_norm)
    k_pe = rotary(k_pe[:, :, None, :], pos)[:, :, 0, :]
    return b_gate, conv_in, q, c_kv, k_pe, g_conv, g_mla


def expand_keys(c_kv, k_pe, w_ukv, k_norm):
    bsz, L, _ = c_kv.shape
    kv = (c_kv @ w_ukv).reshape(bsz, L, N_HEADS, QK_NOPE + V_HEAD)
    k_rot = jnp.broadcast_to(k_pe[:, :, None, :], (bsz, L, N_HEADS, QK_ROPE))
    k = rms_norm(jnp.concatenate([kv[..., :QK_NOPE], k_rot], axis=-1), k_norm)
    return k, kv[..., QK_NOPE:]


def attend(q, k, v, mask):
    s = jnp.einsum("bqhd,bkhd->bhqk", q, k).astype(jnp.float32) * (QK_DIM ** -0.5)
    if mask is not None:
        s = jnp.where(mask[None, None], s, NEG_INF)
    p = jax.nn.softmax(s, axis=-1).astype(v.dtype)
    return jnp.einsum("bhqk,bkhd->bqhd", p, v)


def prompt_attention(q, k, v):
    bsz, L = q.shape[0], q.shape[1]
    n_blk = -(-L // Q_BLOCK)
    L_pad = n_blk * Q_BLOCK
    chunk_id = (jnp.arange(L_pad, dtype=jnp.int32) - N_META) // CHUNK
    key_chunk = chunk_id[:L]
    q_blocks = jnp.pad(q, ((0, 0), (0, L_pad - L), (0, 0), (0, 0)))
    q_blocks = q_blocks.reshape(bsz, n_blk, Q_BLOCK, N_HEADS, QK_DIM).transpose(1, 0, 2, 3, 4)

    def one_block(args):
        qb, qc = args
        return attend(qb, k, v, key_chunk[None, :] <= qc[:, None])

    o = lax.map(one_block, (q_blocks, chunk_id.reshape(n_blk, Q_BLOCK)))
    return o.transpose(1, 0, 2, 3, 4).reshape(bsz, L_pad, N_HEADS * V_HEAD)[:, :L]


def depthwise_causal_conv(x_ext, w):
    return lax.conv_general_dilated(
        x_ext, w[:, None, :].astype(x_ext.dtype), window_strides=(1,), padding="VALID",
        dimension_numbers=("NWC", "WIO", "NWC"), feature_group_count=x_ext.shape[-1])


def merge_branches(x, b_gate, conv_y, attn, g_conv, g_mla, w_conv_out, w_mla_out, w_out_all):
    conv_branch = (b_gate * conv_y) @ w_conv_out
    mla_branch = attn @ w_mla_out
    merged = jax.nn.sigmoid(g_conv) * conv_branch + jax.nn.sigmoid(g_mla) * mla_branch
    return x + merged @ w_out_all


def setup_inputs(seed: int = 0) -> dict:
    key = jax.random.key(seed)
    ks = jax.random.split(key, 32)
    f32 = jnp.float32

    def nrm(k, shape, scale):
        return jax.random.normal(k, shape, f32) * scale

    def gain(k, dim):
        return 1.0 + 0.02 * jax.random.normal(k, (DEPTH, dim), f32)

    return {
        "x_prompt": nrm(ks[0], (BATCH, SEQ, D_MODEL), 1.0),
        "x_sample": nrm(ks[1], (DEC_BATCH, DEC_SEQ, D_MODEL), 1.0),
        "cache_conv": nrm(ks[2], (DEPTH, DEC_BATCH, CONV_WIDTH - 1, D_CONV), 1.0),
        "cache_kv_latent": nrm(ks[3], (DEPTH, DEC_BATCH, PAST_LEN, KV_LORA), 1.0),
        "cache_k_rope": nrm(ks[4], (DEPTH, DEC_BATCH, PAST_LEN, QK_ROPE), 1.0),
        "meta_tokens": nrm(ks[5], (N_META, D_MODEL), 1.0),
        "ffn1_norm": gain(ks[6], D_MODEL),
        "ffn1_w_gate": nrm(ks[7], (DEPTH, D_MODEL, D_FF), D_MODEL ** -0.5),
        "ffn1_w_up": nrm(ks[8], (DEPTH, D_MODEL, D_FF), D_MODEL ** -0.5),
        "ffn1_w_down": nrm(ks[9], (DEPTH, D_FF, D_MODEL), D_FF ** -0.5),
        "mix_norm": gain(ks[10], D_MODEL),
        "w_in_all": nrm(ks[11], (DEPTH, D_MODEL, D_IN_ALL), D_MODEL ** -0.5),
        "conv_w": nrm(ks[12], (DEPTH, CONV_WIDTH, D_CONV), CONV_WIDTH ** -0.5),
        "w_conv_out": nrm(ks[13], (DEPTH, D_CONV, D_MODEL), D_CONV ** -0.5),
        "q_a_norm": gain(ks[14], Q_LORA),
        "w_uq": nrm(ks[15], (DEPTH, Q_LORA, N_HEADS * QK_DIM), Q_LORA ** -0.5),
        "kv_a_norm": gain(ks[16], KV_LORA),
        "w_ukv": nrm(ks[17], (DEPTH, KV_LORA, N_HEADS * (QK_NOPE + V_HEAD)), KV_LORA ** -0.5),
        "q_norm": gain(ks[18], QK_DIM),
        "k_norm": gain(ks[19], QK_DIM),
        "w_mla_out": nrm(ks[20], (DEPTH, N_HEADS * V_HEAD, D_MODEL), (N_HEADS * V_HEAD) ** -0.5),
        "w_out_all": nrm(ks[21], (DEPTH, D_MODEL, D_MODEL), D_MODEL ** -0.5),
        "ffn2_norm": gain(ks[22], D_MODEL),
        "ffn2_w_gate": nrm(ks[23], (DEPTH, D_MODEL, D_FF), D_MODEL ** -0.5),
        "ffn2_w_up": nrm(ks[24], (DEPTH, D_MODEL, D_FF), D_MODEL ** -0.5),
        "ffn2_w_down": nrm(ks[25], (DEPTH, D_FF, D_MODEL), D_FF ** -0.5),
    }


def reference(x_prompt, x_sample, cache_conv, cache_kv_latent, cache_k_rope, meta_tokens,
              ffn1_norm, ffn1_w_gate, ffn1_w_up, ffn1_w_down, mix_norm, w_in_all, conv_w,
              w_conv_out, q_a_norm, w_uq, kv_a_norm, w_ukv, q_norm, k_norm, w_mla_out,
              w_out_all, ffn2_norm, ffn2_w_gate, ffn2_w_up, ffn2_w_down):
    bsz_p = x_prompt.shape[0]
    meta = jnp.broadcast_to(meta_tokens[None].astype(x_prompt.dtype), (bsz_p, N_META, D_MODEL))
    xp = jnp.concatenate([meta, x_prompt], axis=1)
    xs = x_sample
    L_p, L_s = xp.shape[1], xs.shape[1]
    pos_p = jnp.arange(L_p, dtype=jnp.int32)
    pos_s = N_META + PAST_LEN + jnp.arange(L_s, dtype=jnp.int32)

    conv_p_rows, ckv_p_rows, kpe_p_rows = [], [], []
    conv_s_rows, ckv_s_rows, kpe_s_rows = [], [], []
    for l in range(DEPTH):
        xp = half_step_ffn(xp, ffn1_norm[l], ffn1_w_gate[l], ffn1_w_up[l], ffn1_w_down[l])
        xs = half_step_ffn(xs, ffn1_norm[l], ffn1_w_gate[l], ffn1_w_up[l], ffn1_w_down[l])

        bp, cin_p, qp, ckv_p, kpe_p, gcp, gmp = project_inputs(
            rms_norm(xp, mix_norm[l]), pos_p, w_in_all[l], q_a_norm[l], w_uq[l], kv_a_norm[l], q_norm[l])
        bs, cin_s, qs, ckv_s, kpe_s, gcs, gms = project_inputs(
            rms_norm(xs, mix_norm[l]), pos_s, w_in_all[l], q_a_norm[l], w_uq[l], kv_a_norm[l], q_norm[l])

        ext_p = jnp.pad(cin_p, ((0, 0), (CONV_WIDTH - 1, 0), (0, 0)))
        conv_y_p = depthwise_causal_conv(ext_p, conv_w[l])
        ext_s = jnp.concatenate([cache_conv[l].astype(cin_s.dtype), cin_s], axis=1)
        conv_y_s = depthwise_causal_conv(ext_s, conv_w[l])

        k_p, v_p = expand_keys(ckv_p, kpe_p, w_ukv[l], k_norm[l])
        attn_p = prompt_attention(qp, k_p, v_p)
        ckv_all = jnp.concatenate([cache_kv_latent[l].astype(ckv_s.dtype), ckv_s], axis=1)
        kpe_all = jnp.concatenate([cache_k_rope[l].astype(kpe_s.dtype), kpe_s], axis=1)
        k_s, v_s = expand_keys(ckv_all, kpe_all, w_ukv[l], k_norm[l])
        attn_s = attend(qs, k_s, v_s, None).reshape(xs.shape[0], L_s, N_HEADS * V_HEAD)

        xp = merge_branches(xp, bp, conv_y_p, attn_p, gcp, gmp, w_conv_out[l], w_mla_out[l], w_out_all[l])
        xs = merge_branches(xs, bs, conv_y_s, attn_s, gcs, gms, w_conv_out[l], w_mla_out[l], w_out_all[l])

        xp = half_step_ffn(xp, ffn2_norm[l], ffn2_w_gate[l], ffn2_w_up[l], ffn2_w_down[l])
        xs = half_step_ffn(xs, ffn2_norm[l], ffn2_w_gate[l], ffn2_w_up[l], ffn2_w_down[l])

        conv_p_rows.append(ext_p[:, -(CONV_WIDTH - 1):])
        ckv_p_rows.append(ckv_p)
        kpe_p_rows.append(kpe_p)
        conv_s_rows.append(ext_s[:, -(CONV_WIDTH - 1):])
        ckv_s_rows.append(ckv_s)
        kpe_s_rows.append(kpe_s)

    y_prompt = xp[:, N_META:]
    y_sample = xs
    new_conv_prompt = jnp.stack(conv_p_rows)
    new_kv_latent_prompt = jnp.stack(ckv_p_rows)
    new_k_rope_prompt = jnp.stack(kpe_p_rows)
    new_conv_sample = jnp.stack(conv_s_rows)
    new_kv_latent_sample = jnp.stack(ckv_s_rows)
    new_k_rope_sample = jnp.stack(kpe_s_rows)
    return (y_prompt, y_sample, new_conv_prompt, new_kv_latent_prompt, new_k_rope_prompt,
            new_conv_sample, new_kv_latent_sample, new_k_rope_sample)
```

```cpp
#include <hip/hip_runtime.h>
#include <hip/hip_cooperative_groups.h>
#include <cstdio>
namespace cg = cooperative_groups;

#ifndef N_LAUNCH_MODE
#define N_LAUNCH_MODE 1
#endif

#define LAS __attribute__((address_space(3)))
#define DI __device__ __forceinline__
typedef unsigned short bf16_t;
typedef short bf16x8 __attribute__((ext_vector_type(8)));
typedef float f32x4 __attribute__((ext_vector_type(4)));
typedef float f32x2 __attribute__((ext_vector_type(2)));
typedef float f32x16 __attribute__((ext_vector_type(16)));
typedef unsigned u32x4 __attribute__((ext_vector_type(4)));
typedef unsigned u32x2 __attribute__((ext_vector_type(2)));
typedef __bf16 bf16v2 __attribute__((ext_vector_type(2)));

constexpr int D = 1024, FF = 2816, NB = 16, LP = 4112, DS = 32, PAST = 2048;
constexpr int MP = NB * LP;
constexpr int MS = NB * DS;
constexpr int M = MP + MS;
constexpr int LSK = PAST + DS;
constexpr int MK = MP + NB * LSK;
constexpr int MKP = MK + 64;
constexpr int NIN = 5888;
constexpr float EPS = 1e-6f;

constexpr size_t OFF_W1GU = 0;
constexpr size_t OFF_W1D = OFF_W1GU + (size_t)5632 * 1024 * 2;
constexpr size_t OFF_WIN = OFF_W1D + (size_t)1024 * 2816 * 2;
constexpr size_t OFF_WUQ = OFF_WIN + (size_t)NIN * 1024 * 2;
constexpr size_t OFF_WK = OFF_WUQ + (size_t)1536 * 384 * 2;
constexpr size_t OFF_WVT = OFF_WK + (size_t)1024 * 256 * 2;
constexpr size_t OFF_WCO = OFF_WVT + (size_t)1024 * 256 * 2;
constexpr size_t OFF_WMO = OFF_WCO + (size_t)1024 * 1024 * 2;
constexpr size_t OFF_WOUT = OFF_WMO + (size_t)1024 * 1024 * 2;
constexpr size_t OFF_W2GU = OFF_WOUT + (size_t)1024 * 1024 * 2;
constexpr size_t OFF_W2D = OFF_W2GU + (size_t)5632 * 1024 * 2;
constexpr size_t OFF_ROT = OFF_W2D + (size_t)1024 * 2816 * 2;
constexpr size_t OFF_RQ = OFF_ROT + (size_t)LP * 16 * 8;
constexpr size_t OFF_XM = OFF_RQ + (size_t)M * 4;
constexpr size_t OFF_BAR = OFF_XM + (size_t)256 * 1024 * 4;
constexpr size_t RB = (size_t)60 << 20;
static_assert(OFF_BAR + 16384 <= RB, "weights region overflow");
static_assert(OFF_XM % 16 == 0 && OFF_RQ % 16 == 0 && OFF_ROT % 16 == 0, "align");
constexpr size_t EU = (size_t)M * 256;
constexpr size_t OFF_H = RB + 0 * EU;
constexpr size_t OFF_GM = RB + 8 * EU;
constexpr size_t OFF_ZQ = RB + 16 * EU;
constexpr size_t OFF_CKV = RB + 19 * EU;
constexpr size_t OFF_KPE = RB + 22 * EU;
constexpr size_t OFF_BG = RB + 23 * EU;
constexpr size_t OFF_CIN = RB + 31 * EU;
constexpr size_t OFF_GC = RB + 39 * EU;
constexpr size_t OFF_ZL = RB + 47 * EU;
constexpr size_t OFF_QR = RB + 23 * EU;
constexpr size_t OFF_KH = RB + 35 * EU;
constexpr size_t OFF_VT = RB + 44 * EU;
constexpr size_t OFF_ATT = RB + 51 * EU;
constexpr size_t OFF_MG = RB + 35 * EU;
constexpr size_t OFF_ACT = RB + 8 * EU;
constexpr size_t WS_END = RB + 59 * EU;
static_assert((size_t)MKP * 256 * 2 <= 3 * EU && (size_t)MKP * 32 * 2 <= EU && (size_t)M * 160 * 4 <= 3 * EU, "region sizes");
constexpr int NVT = 16 * 65 + 16 * 33;
static_assert((size_t)MKP * 768 * 2 <= 9 * EU && (size_t)8 * NVT * 4096 * 2 <= 7 * EU, "kv region sizes");

constexpr size_t OUT_YP = 0;
constexpr size_t OUT_YS = OUT_YP + (size_t)NB * 4096 * 1024;
constexpr size_t OUT_NCP = OUT_YS + (size_t)MS * 1024;
constexpr size_t OUT_KVP = OUT_NCP + (size_t)NB * 2 * 1024;
constexpr size_t OUT_KRP = OUT_KVP + (size_t)MP * 128;
constexpr size_t OUT_NCS = OUT_KRP + (size_t)MP * 32;
constexpr size_t OUT_KVS = OUT_NCS + (size_t)NB * 2 * 1024;
constexpr size_t OUT_KRS = OUT_KVS + (size_t)MS * 128;

struct Params {
    const float* in[26];
    float* out;
    unsigned char* ws;
    int ph_lo, ph_hi;
};
enum { I_XP = 0, I_XS, I_CCONV, I_CKV, I_CKR, I_META, I_F1N, I_F1G, I_F1U, I_F1D, I_MIXN, I_WIN, I_CONVW, I_WCO, I_QAN, I_WUQ, I_KVAN, I_WUKV, I_QN, I_KN, I_WMO, I_WOUT, I_F2N, I_F2G, I_F2U, I_F2D };

DI unsigned pk2(float a, float b) { bf16v2 v = __builtin_convertvector((f32x2){a, b}, bf16v2); return __builtin_bit_cast(unsigned, v); }
DI float bflo(unsigned u) { return __uint_as_float(u << 16); }
DI float bfhi(unsigned u) { return __uint_as_float(u & 0xffff0000u); }
DI float wave_sum(float v) {
#pragma unroll
    for (int o = 1; o < 64; o <<= 1) v += __shfl_xor(v, o);
    return v;
}
DI float* xrow_dst(const Params& p, int r) {
    if (r < MP) { const int b = r / LP, i = r - b * LP;
        if (i >= 16) return p.out + OUT_YP + ((size_t)b * 4096 + (i - 16)) * 1024;
        return (float*)(p.ws + OFF_XM) + (size_t)(b * 16 + i) * 1024; }
    return p.out + OUT_YS + (size_t)(r - MP) * 1024;
}
DI const float* xrow_src0(const Params& p, int r) {
    if (r < MP) { const int b = r / LP, i = r - b * LP;
        if (i >= 16) return p.in[I_XP] + ((size_t)b * 4096 + (i - 16)) * 1024;
        return p.in[I_META] + (size_t)i * 1024; }
    return p.in[I_XS] + (size_t)(r - MP) * 1024;
}


#define XB_TMO      128
#define XB_XCNT(j)  (256  + 64 * (j))
#define XB_XSUB(j)  (1280 + 64 * (j))
#define XB_XGEN(j)  (2304 + 64 * (j))
#define XB_TOP      3328
#define XB_TOPGEN   3392
#define XCD_BAR_WORDS 3456
#define XB_SPIN_CAP (1u << 22)
DI unsigned xb_ld(unsigned* p) { return __hip_atomic_load(p, __ATOMIC_RELAXED, __HIP_MEMORY_SCOPE_AGENT); }
DI unsigned xb_add(unsigned* p, unsigned v) { return __hip_atomic_fetch_add(p, v, __ATOMIC_RELAXED, __HIP_MEMORY_SCOPE_AGENT); }
DI unsigned xb_xcc_id() { return (unsigned)__builtin_amdgcn_s_getreg((3 << 11) | 20) & 0xFu; }
#define XB_SPIN(cond, bar) do { unsigned _sp = 0; while (cond) { __builtin_amdgcn_s_sleep(1); \
    if ((++_sp & 255u) == 0u) { if (xb_ld(&(bar)[XB_TMO])) break; if (_sp > XB_SPIN_CAP) { atomicAdd(&(bar)[XB_TMO], 1u); break; } } } } while (0)
struct XcdBarrier { unsigned* bar; unsigned x; volatile LAS unsigned* st; };
DI void xcd_barrier_complete(unsigned* bar, unsigned x, unsigned& nloc, unsigned& nx) {
    const unsigned G = gridDim.x;
    unsigned sum, cnt, mine, sp = 0u;
    for (;;) {
        sum = 0u; cnt = 0u; mine = 0u;
#pragma unroll
        for (unsigned j = 0; j < 16; ++j) { const unsigned c = xb_ld(&bar[XB_XCNT(j)]); sum += c; cnt += (c > 0u) ? 1u : 0u; mine = (j == x) ? c : mine; }
        if (sum == G) break;
        __builtin_amdgcn_s_sleep(1);
        if ((++sp & 255u) == 0u) { if (xb_ld(&bar[XB_TMO])) break; if (sp > XB_SPIN_CAP) { atomicAdd(&bar[XB_TMO], 1u); break; } }
    }
    nloc = mine > 0u ? mine : 1u; nx = cnt > 0u ? cnt : 1u;
}
DI void xcd_barrier(const XcdBarrier& b) {
    asm volatile("s_waitcnt vmcnt(0)" ::: "memory");
    __syncthreads();
    if (threadIdx.x == 0) {
        unsigned* bar = b.bar;
        __builtin_amdgcn_s_waitcnt(0);
        unsigned nloc = b.st[0], nx = b.st[1];
        if (nloc == 0u) { xcd_barrier_complete(bar, b.x, nloc, nx); b.st[0] = nloc; b.st[1] = nx; }
        const unsigned old = xb_add(&bar[XB_XSUB(b.x)], 1u);
        const unsigned gen = old / nloc;
        if (old + 1u == (gen + 1u) * nloc) {
            __builtin_amdgcn_fence(__ATOMIC_RELEASE, "agent");
            asm volatile("s_waitcnt vmcnt(0)" ::: "memory");
            const unsigned og = xb_add(&bar[XB_TOP], 1u);
            const unsigned tg = og / nx;
            if (og + 1u == (tg + 1u) * nx) xb_add(&bar[XB_TOPGEN], 1u);
            else XB_SPIN(xb_ld(&bar[XB_TOPGEN]) == tg, bar);
            __builtin_amdgcn_fence(__ATOMIC_ACQUIRE, "agent");
            xb_add(&bar[XB_XGEN(b.x)], 1u);
            asm volatile("s_waitcnt vmcnt(0)" ::: "memory");
        } else {
            XB_SPIN(xb_ld(&bar[XB_XGEN(b.x)]) == gen, bar);
            __builtin_amdgcn_fence(__ATOMIC_ACQUIRE, "agent");
            asm volatile("s_waitcnt vmcnt(0)" ::: "memory");
        }
    }
    __syncthreads();
}

namespace pg8 {
constexpr int BM = 256, BK = 64, HALF = 128, HTB = HALF * BK * 2, STAGE_BYTES = 8 * HTB, NXCD = 8, WGM = 8;
DI int lds_byte(int r, int c) { const int st = (r >> 4) * 2 + (c >> 5), rr = r & 15, cc = c & 31, ob = rr * 64 + cc * 2; return st * 1024 + (ob ^ (((ob >> 9) & 1) << 5)); }
DI void stage_rc(int b, int& R, int& C) { const int st = b / 1024, sb = b % 1024, swz = sb ^ (((sb >> 9) & 1) << 5); R = (st >> 1) * 16 + swz / 64; C = (st & 1) * 32 + (swz % 64) / 2; }
struct Unit { int pm, pn, ks; };
struct Gemm { const bf16_t* A; const bf16_t* Bt; int M, N, K, ld; };
struct StaticOrder {
    int nM, nN, nwg, G, c;
    DI void init(int M_, int N_, int G_, int c_) { nM = M_ / BM; nN = N_ / BM; nwg = nM * nN; G = G_; c = c_; }
    DI bool next(int i, Unit& u) const {
        const long L = (long)i * G + c; if (L >= nwg) return false;
        int wgid = (int)L; { const int q = nwg / NXCD, r = nwg % NXCD, xcd = wgid % NXCD, off = wgid / NXCD; wgid = (xcd < r ? xcd * (q + 1) : r * (q + 1) + (xcd - r) * q) + off; }
        const int nig = WGM * nN, gid = wgid / nig, fm = gid * WGM, gsz = (nM - fm) < WGM ? (nM - fm) : WGM;
        u.pm = fm + ((wgid % nig) % gsz); u.pn = (wgid % nig) / gsz; u.ks = 0; return true;
    }
};
struct TailOrder {
    int pm0, npm, nN, S, G, c;
    DI bool next(int i, Unit& u) const {
        const long L = (long)i * G + c; if (L >= (long)npm * nN * S) return false;
        const int l = (int)L; u.ks = l % S; const int t = l / S; u.pn = t % nN; u.pm = pm0 + t / nN; return true;
    }
};
template <class Epi, class Sched>
DI void gemm_phase(LAS unsigned char* lds, const Gemm g, const Sched& S, const Epi& E) {
    const int tid = threadIdx.x, wid = __builtin_amdgcn_readfirstlane(tid >> 6), lane = tid & 63, wr = wid >> 2, wc = wid & 3, fr = lane & 15, fq = lane >> 4;
    const int K = g.K, nt = K / BK, ld = g.ld;
    unsigned voffA[2], voffB[2];
#pragma unroll
    for (int i = 0; i < 2; ++i) { int R, C; stage_rc(tid * 16 + i * 8192, R, C); voffA[i] = (unsigned)(R * ld + C) * 2u;
        const int r32 = R & 31, Rb = Epi::PERMB ? (R & ~31) + 8 * ((r32 >> 2) & 3) + 4 * (r32 >> 4) + (r32 & 3) : R; voffB[i] = (unsigned)(Rb * ld + C) * 2u; }
    const size_t kstep = (size_t)(BK * 2);
    const size_t hstep = (size_t)HALF * ld * 2;
    const size_t tstep = 2 * hstep;
    const unsigned ldsw = (unsigned)wid * 1024u;
    const int aoff = lds_byte(wr * 64 + fr, fq * 8), boff = lds_byte(wc * 32 + fr, fq * 8);
#define PG8_SA(b, h) (((b) * 2 + (h)) * HTB)
#define PG8_SB(b, h) ((4 + (b) * 2 + (h)) * HTB)
#define PG8_STAGE(bufoff, gbase, voff) do { _Pragma("unroll") for (int _i = 0; _i < 2; ++_i) \
        __builtin_amdgcn_global_load_lds((const unsigned*)((const char*)(gbase) + (voff)[_i]), (LAS unsigned*)(lds + (bufoff) + ldsw + _i * 8192), 16, 0, 0); } while (0)
#define PG8_LDA(dst, b, h) do { _Pragma("unroll") for (int m = 0; m < 4; ++m) _Pragma("unroll") for (int k = 0; k < 2; ++k) dst[m][k] = *(const LAS bf16x8*)(lds + PG8_SA(b, h) + aoff + m * 2048 + k * 1024); } while (0)
#define PG8_LDB(dst, b, h) do { _Pragma("unroll") for (int n = 0; n < 2; ++n) _Pragma("unroll") for (int k = 0; k < 2; ++k) dst[n][k] = *(const LAS bf16x8*)(lds + PG8_SB(b, h) + boff + n * 2048 + k * 1024); } while (0)
#define PG8_MMA(ai, bj, At, Bt) do { __builtin_amdgcn_s_setprio(1); _Pragma("unroll") for (int m = 0; m < 4; ++m) _Pragma("unroll") for (int n = 0; n < 2; ++n) _Pragma("unroll") for (int k = 0; k < 2; ++k) \
        acc[ai][bj][m][n] = __builtin_amdgcn_mfma_f32_16x16x32_bf16(Bt[n][k], At[m][k], acc[ai][bj][m][n], 0, 0, 0); __builtin_amdgcn_s_setprio(0); } while (0)
#define PG8_WAIT_V(n) asm volatile("s_waitcnt vmcnt(" #n ")" ::: "memory")
#define PG8_WAIT_L(n) asm volatile("s_waitcnt lgkmcnt(" #n ")" ::: "memory")
#define PG8_BAR __builtin_amdgcn_s_barrier()
#define PG8_SCHED __builtin_amdgcn_sched_barrier(0)
    Unit cur, nxt; int ui = 0;
    if (!S.next(0, cur)) return;
    f32x4 acc[2][2][4][2];
#pragma unroll
    for (int a = 0; a < 2; ++a)
#pragma unroll
        for (int b = 0; b < 2; ++b)
#pragma unroll
            for (int m = 0; m < 4; ++m)
#pragma unroll
                for (int n = 0; n < 2; ++n) acc[a][b][m][n] = (f32x4){0.f, 0.f, 0.f, 0.f};
    bf16x8 At[4][2], B0[2][2], B1[2][2];
    const char* cA = (const char*)g.A + (size_t)cur.pm * tstep + (size_t)cur.ks * K * 2; const char* cB = (const char*)g.Bt + (size_t)cur.pn * tstep + (size_t)cur.ks * K * 2;
    PG8_STAGE(PG8_SB(0, 0), cB, voffB); PG8_STAGE(PG8_SA(0, 0), cA, voffA); PG8_STAGE(PG8_SB(0, 1), cB + hstep, voffB); PG8_STAGE(PG8_SA(0, 1), cA + hstep, voffA);
    if (wr == 1) PG8_BAR;
    PG8_WAIT_V(4); PG8_BAR;
    PG8_STAGE(PG8_SB(1, 0), cB + kstep, voffB); PG8_STAGE(PG8_SA(1, 0), cA + kstep, voffA); PG8_STAGE(PG8_SB(1, 1), cB + hstep + kstep, voffB);
    PG8_WAIT_V(6); PG8_BAR;
    for (;;) {
        const bool has_next = S.next(ui + 1, nxt);
        const char* nA = has_next ? (const char*)g.A + (size_t)nxt.pm * tstep + (size_t)nxt.ks * K * 2 : cA; const char* nB = has_next ? (const char*)g.Bt + (size_t)nxt.pn * tstep + (size_t)nxt.ks * K * 2 : cB;
#pragma unroll 1
        for (int t = 0; t < nt; t += 2) {
            const bool last = (t == nt - 2);
            const char* a1 = cA + (size_t)(t + 1) * kstep;
            const char* a2 = last ? nA : cA + (size_t)(t + 2) * kstep; const char* b2 = last ? nB : cB + (size_t)(t + 2) * kstep;
            const char* a3 = a2 + kstep; const char* b3 = b2 + kstep;
            PG8_LDB(B0, 0, 0); PG8_SCHED; PG8_LDA(At, 0, 0); PG8_STAGE(PG8_SA(1, 1), a1 + hstep, voffA);
            PG8_WAIT_L(8); PG8_BAR; PG8_WAIT_L(0); PG8_MMA(0, 0, At, B0); PG8_BAR; PG8_SCHED;
            PG8_LDB(B1, 0, 1); PG8_STAGE(PG8_SB(0, 0), b2, voffB);
            PG8_BAR; PG8_WAIT_L(0); PG8_MMA(0, 1, At, B1); PG8_BAR;
            PG8_LDA(At, 0, 1); PG8_STAGE(PG8_SA(0, 0), a2, voffA);
            PG8_BAR; PG8_WAIT_L(0); PG8_MMA(1, 0, At, B0); PG8_BAR; PG8_SCHED;
            PG8_STAGE(PG8_SB(0, 1), b2 + hstep, voffB);
            PG8_WAIT_V(6); PG8_BAR; PG8_MMA(1, 1, At, B1); PG8_BAR;
            PG8_LDB(B0, 1, 0); PG8_SCHED; PG8_LDA(At, 1, 0); PG8_STAGE(PG8_SA(0, 1), a2 + hstep, voffA);
            PG8_WAIT_L(8); PG8_BAR; PG8_WAIT_L(0); PG8_MMA(0, 0, At, B0); PG8_BAR; PG8_SCHED;
            PG8_LDB(B1, 1, 1); PG8_STAGE(PG8_SB(1, 0), b3, voffB);
            PG8_BAR; PG8_WAIT_L(0); PG8_MMA(0, 1, At, B1); PG8_BAR;
            PG8_LDA(At, 1, 1); PG8_STAGE(PG8_SA(1, 0), a3, voffA);
            PG8_BAR; PG8_WAIT_L(0); PG8_MMA(1, 0, At, B0); PG8_BAR; PG8_SCHED;
            PG8_STAGE(PG8_SB(1, 1), b3 + hstep, voffB);
            PG8_WAIT_V(6); PG8_BAR; PG8_MMA(1, 1, At, B1); PG8_BAR;
        }
        E(acc, cur, wr, wc, fr, fq);
        if (!has_next) break;
#pragma unroll
        for (int a = 0; a < 2; ++a)
#pragma unroll
            for (int b = 0; b < 2; ++b)
#pragma unroll
                for (int m = 0; m < 4; ++m)
#pragma unroll
                    for (int n = 0; n < 2; ++n) acc[a][b][m][n] = (f32x4){0.f, 0.f, 0.f, 0.f};
        cur = nxt; cA = nA; cB = nB; ++ui;
    }
    PG8_WAIT_V(0);
    if (wr == 0) PG8_BAR;
    PG8_BAR;
#undef PG8_SA
#undef PG8_SB
#undef PG8_STAGE
#undef PG8_LDA
#undef PG8_LDB
#undef PG8_MMA
#undef PG8_WAIT_V
#undef PG8_WAIT_L
#undef PG8_BAR
#undef PG8_SCHED
}
}
using pg8::Unit;
typedef f32x4 Acc[2][2][4][2];

DI int fresh_lane() { int l; asm volatile("v_mbcnt_lo_u32_b32 %0, -1, 0\n\tv_mbcnt_hi_u32_b32 %0, -1, %0" : "=v"(l)); return l; }
#define EPI_ROWS(ai, m) for (int ai = 0; ai < 2; ++ai) _Pragma("unroll") for (int m = 0; m < 4; ++m)
DI void st_bf4(bf16_t* p, f32x4 v) { u32x2 w; w.x = pk2(v[0], v[1]); w.y = pk2(v[2], v[3]); *(u32x2*)p = w; }
DI float sigm2(float x) { return __builtin_amdgcn_rcpf(1.0f + __builtin_amdgcn_exp2f(-x)); }

DI void st_bf8(bf16_t* p, f32x4 a, f32x4 b) { u32x4 w; w.x = pk2(a[0], a[1]); w.y = pk2(a[2], a[3]); w.z = pk2(b[0], b[1]); w.w = pk2(b[2], b[3]); *(u32x4*)p = w; }
struct EpiSwiglu {
    static constexpr bool PERMB = false;
    bf16_t* O;
    DI void operator()(const Acc& acc, const Unit& u, int wr, int wc, int fr_, int fq_) const {
        const int lane_ = fresh_lane(), fr = lane_ & 15, fq = lane_ >> 4;
        const int row0 = u.pm * 256 + wr * 64 + fr, col0 = u.pn * 128 + wc * 32 + 8 * fq;
#pragma unroll
        EPI_ROWS(ai, m) { bf16_t* rp = O + (size_t)(row0 + ai * 128 + m * 16) * FF + col0; f32x4 v[2];
#pragma unroll
            for (int n = 0; n < 2; ++n) { const f32x4 g = acc[ai][0][m][n], up = acc[ai][1][m][n];
#pragma unroll
                for (int j = 0; j < 4; ++j) v[n][j] = g[j] * up[j] * sigm2(g[j]); }
            st_bf8(rp, v[0], v[1]); }
    }
};
struct EpiResid {
    static constexpr bool PERMB = false;
    const float *xp, *meta, *xs; float* out; float* xm; int src0; float scale;
    DI float* drow(int r) const {
        if (r < MP) { const int b = r / LP, i = r - b * LP;
            if (i >= 16) return out + OUT_YP + ((size_t)b * 4096 + (i - 16)) * 1024;
            return xm + (size_t)(b * 16 + i) * 1024; }
        return out + OUT_YS + (size_t)(r - MP) * 1024; }
    DI const float* srow(int r) const {
        if (r < MP) { const int b = r / LP, i = r - b * LP;
            if (i >= 16) return xp + ((size_t)b * 4096 + (i - 16)) * 1024;
            return meta + (size_t)i * 1024; }
        return xs + (size_t)(r - MP) * 1024; }
    DI void operator()(const Acc& acc, const Unit& u, int wr, int wc, int fr_, int fq_) const {
        const int lane_ = fresh_lane(), fr = lane_ & 15, fq = lane_ >> 4;
        const int row0 = u.pm * 256 + wr * 64 + fr, col0 = u.pn * 256 + wc * 32 + 8 * fq;
        f32x4 xa[2][2][2], xb[2][2][2];
#define ER_LOAD(X, Q) do { _Pragma("unroll") for (int mm = 0; mm < 2; ++mm) { const int r_ = row0 + ((Q) >> 1) * 128 + (2 * ((Q) & 1) + mm) * 16; \
            const float* sp_ = (src0 ? srow(r_) : (const float*)drow(r_)) + col0; \
            _Pragma("unroll") for (int bj = 0; bj < 2; ++bj) _Pragma("unroll") for (int n = 0; n < 2; ++n) X[mm][bj][n] = *(const f32x4*)(sp_ + bj * 128 + n * 4); } } while (0)
#define ER_STORE(X, Q) do { _Pragma("unroll") for (int mm = 0; mm < 2; ++mm) { const int r_ = row0 + ((Q) >> 1) * 128 + (2 * ((Q) & 1) + mm) * 16; float* dp_ = drow(r_) + col0; \
            _Pragma("unroll") for (int bj = 0; bj < 2; ++bj) _Pragma("unroll") for (int n = 0; n < 2; ++n) \
                *(f32x4*)(dp_ + bj * 128 + n * 4) = X[mm][bj][n] + scale * acc[(Q) >> 1][bj][2 * ((Q) & 1) + mm][n]; } } while (0)
        ER_LOAD(xa, 0); ER_LOAD(xb, 1);
        ER_STORE(xa, 0); ER_LOAD(xa, 2);
        ER_STORE(xb, 1); ER_LOAD(xb, 3);
        ER_STORE(xa, 2); ER_STORE(xb, 3);
#undef ER_LOAD
#undef ER_STORE
    }
};
constexpr int M_MAIN = 65536, NTAILP = (M - M_MAIN) / 256;
struct EpiPartial {
    static constexpr bool PERMB = false;
    float* P;
    DI void operator()(const Acc& acc, const Unit& u, int wr, int wc, int fr_, int fq_) const {
        const int lane_ = fresh_lane(), fr = lane_ & 15, fq = lane_ >> 4;
        float* base = P + (size_t)((u.ks * NTAILP + (u.pm - M_MAIN / 256)) * 4 + u.pn) * 65536 + (size_t)(wr * 64 + fr) * 256 + wc * 32 + 8 * fq;
#pragma unroll
        EPI_ROWS(ai, m)
#pragma unroll
            for (int bj = 0; bj < 2; ++bj)
#pragma unroll
                for (int n = 0; n < 2; ++n) *(f32x4*)(base + (size_t)(ai * 128 + m * 16) * 256 + bj * 128 + n * 4) = acc[ai][bj][m][n];
    }
};
struct EpiInProj {
    static constexpr bool PERMB = false;
    bf16_t *BG, *CIN, *GC, *GM, *ZQ; float* ZL;
    DI void operator()(const Acc& acc, const Unit& u, int wr, int wc, int fr_, int fq_) const {
        const int lane_ = fresh_lane(), fr = lane_ & 15, fq = lane_ >> 4;
        const int row0 = u.pm * 256 + wr * 64 + fr, T = u.pn, cw = wc * 32 + 8 * fq;
        if (T >= 4 && T < 12) {
#pragma unroll
            EPI_ROWS(ai, m) st_bf8(CIN + (size_t)(row0 + ai * 128 + m * 16) * 1024 + (T - 4) * 128 + cw, acc[ai][0][m][0] * acc[ai][1][m][0], acc[ai][0][m][1] * acc[ai][1][m][1]);
        } else if (T < 4 || T == 20) {
            bf16_t* base = T < 4 ? BG + T * 256 : ZQ; const int ld = T < 4 ? 1024 : 384;
#pragma unroll
            EPI_ROWS(ai, m) { bf16_t* rp = base + (size_t)(row0 + ai * 128 + m * 16) * ld + cw;
#pragma unroll
                for (int bj = 0; bj < 2; ++bj) st_bf8(rp + bj * 128, acc[ai][bj][m][0], acc[ai][bj][m][1]); }
        } else if (T < 20) {
            bf16_t* base = T < 16 ? GC + (T - 12) * 256 : GM + (T - 16) * 256;
#pragma unroll
            EPI_ROWS(ai, m) { bf16_t* rp = base + (size_t)(row0 + ai * 128 + m * 16) * 1024 + cw;
#pragma unroll
                for (int bj = 0; bj < 2; ++bj) { f32x4 v[2];
#pragma unroll
                    for (int n = 0; n < 2; ++n)
#pragma unroll
                        for (int j = 0; j < 4; ++j) v[n][j] = sigm2(acc[ai][bj][m][n][j]);
                    st_bf8(rp + bj * 128, v[0], v[1]); } }
        } else if (T == 21) {
#pragma unroll
            EPI_ROWS(ai, m) { const size_t r = (size_t)(row0 + ai * 128 + m * 16);
                st_bf8(ZQ + r * 384 + 256 + cw, acc[ai][0][m][0], acc[ai][0][m][1]);
                *(f32x4*)(ZL + r * 160 + cw) = acc[ai][1][m][0]; *(f32x4*)(ZL + r * 160 + cw + 4) = acc[ai][1][m][1]; }
        } else {
            if (wc == 0) {
#pragma unroll
                EPI_ROWS(ai, m) { const size_t r = (size_t)(row0 + ai * 128 + m * 16);
                    *(f32x4*)(ZL + r * 160 + 128 + 8 * fq) = acc[ai][0][m][0]; *(f32x4*)(ZL + r * 160 + 128 + 8 * fq + 4) = acc[ai][0][m][1]; }
            }
        }
    }
};
struct EpiQup {
    static constexpr bool PERMB = false;
    bf16_t* O; const float* rq;
    DI void operator()(const Acc& acc, const Unit& u, int wr, int wc, int fr_, int fq_) const {
        const int lane_ = fresh_lane(), fr = lane_ & 15, fq = lane_ >> 4;
        const int row0 = u.pm * 256 + wr * 64 + fr, col0 = u.pn * 256 + wc * 32 + 8 * fq;
        float sc[2][4];
#pragma unroll
        for (int ai = 0; ai < 2; ++ai)
#pragma unroll
            for (int m = 0; m < 4; ++m) sc[ai][m] = rq[row0 + ai * 128 + m * 16];
#pragma unroll
        EPI_ROWS(ai, m) { const int r = row0 + ai * 128 + m * 16; const float s = sc[ai][m]; bf16_t* rp = O + (size_t)r * 1536 + col0;
#pragma unroll
            for (int bj = 0; bj < 2; ++bj) st_bf8(rp + bj * 128, acc[ai][bj][m][0] * s, acc[ai][bj][m][1] * s); }
    }
};
struct EpiGate {
    static constexpr bool PERMB = false;
    bf16_t* O; const bf16_t* gate; const bf16_t* add;
    DI void operator()(const Acc& acc, const Unit& u, int wr, int wc, int fr_, int fq_) const {
        const int lane_ = fresh_lane(), fr = lane_ & 15, fq = lane_ >> 4;
        const int row0 = u.pm * 256 + wr * 64 + fr, col0 = u.pn * 256 + wc * 32 + 8 * fq;
        u32x4 ga[2][2], aa[2][2], gb[2][2], ab[2][2];
#define EG_LOAD(G, A, Q) do { _Pragma("unroll") for (int mm = 0; mm < 2; ++mm) _Pragma("unroll") for (int bj = 0; bj < 2; ++bj) { \
            const size_t oo_ = (size_t)(row0 + ((Q) >> 1) * 128 + (2 * ((Q) & 1) + mm) * 16) * 1024 + col0 + bj * 128; \
            G[mm][bj] = *(const u32x4*)(gate + oo_); A[mm][bj] = add ? *(const u32x4*)(add + oo_) : (u32x4){0u, 0u, 0u, 0u}; } } while (0)
#define EG_STORE(G, A, Q) do { _Pragma("unroll") for (int mm = 0; mm < 2; ++mm) _Pragma("unroll") for (int bj = 0; bj < 2; ++bj) { \
            const size_t oo_ = (size_t)(row0 + ((Q) >> 1) * 128 + (2 * ((Q) & 1) + mm) * 16) * 1024 + col0 + bj * 128; \
            const u32x4 g = G[mm][bj], a2 = A[mm][bj]; const f32x4 a = acc[(Q) >> 1][bj][2 * ((Q) & 1) + mm][0], c = acc[(Q) >> 1][bj][2 * ((Q) & 1) + mm][1]; \
            st_bf8(O + oo_, (f32x4){bflo(a2.x) + bflo(g.x) * a[0], bfhi(a2.x) + bfhi(g.x) * a[1], bflo(a2.y) + bflo(g.y) * a[2], bfhi(a2.y) + bfhi(g.y) * a[3]}, \
                            (f32x4){bflo(a2.z) + bflo(g.z) * c[0], bfhi(a2.z) + bfhi(g.z) * c[1], bflo(a2.w) + bflo(g.w) * c[2], bfhi(a2.w) + bfhi(g.w) * c[3]}); } } while (0)
        EG_LOAD(ga, aa, 0); EG_LOAD(gb, ab, 1);
        EG_STORE(ga, aa, 0); EG_LOAD(ga, aa, 2);
        EG_STORE(gb, ab, 1); EG_LOAD(gb, ab, 3);
        EG_STORE(ga, aa, 2); EG_STORE(gb, ab, 3);
#undef EG_LOAD
#undef EG_STORE
    }
};
struct EpiK {
    static constexpr bool PERMB = false;
    bf16_t* K; const bf16_t* KPE; const float* kg_;
    DI void operator()(const Acc& acc, const Unit& u, int wr, int wc, int fr_, int fq_) const {
        const int lane_ = fresh_lane(), fr = lane_ & 15, fq = lane_ >> 4;
        const int row0 = u.pm * 256 + wr * 64 + fr, hl = 4 * u.pn + wc;
        const float* kg = kg_; asm volatile("" : "+s"(kg));
        f32x4 g[2][2]; f32x4 gr0 = *(const f32x4*)(kg + 64 + 8 * fq), gr1 = *(const f32x4*)(kg + 68 + 8 * fq);
#pragma unroll
        for (int bj = 0; bj < 2; ++bj)
#pragma unroll
            for (int n = 0; n < 2; ++n) g[bj][n] = *(const f32x4*)(kg + 32 * bj + 8 * fq + 4 * n);
        u32x4 kpv[2][4];
#pragma unroll
        for (int ai = 0; ai < 2; ++ai)
#pragma unroll
            for (int m = 0; m < 4; ++m) kpv[ai][m] = *(const u32x4*)(KPE + (size_t)(row0 + ai * 128 + m * 16) * 32 + 8 * fq);
#pragma unroll
        EPI_ROWS(ai, m) { const int r = row0 + ai * 128 + m * 16;
            const u32x4 kp = kpv[ai][m];
            f32x4 r0 = (f32x4){bflo(kp.x), bfhi(kp.x), bflo(kp.y), bfhi(kp.y)}, r1 = (f32x4){bflo(kp.z), bfhi(kp.z), bflo(kp.w), bfhi(kp.w)};
            float ss = 0.f;
#pragma unroll
            for (int j = 0; j < 4; ++j) ss += r0[j] * r0[j] + r1[j] * r1[j];
#pragma unroll
            for (int bj = 0; bj < 2; ++bj)
#pragma unroll
                for (int n = 0; n < 2; ++n) { const f32x4 a = acc[ai][bj][m][n]; ss += (a[0] * a[0] + a[1] * a[1]) + (a[2] * a[2] + a[3] * a[3]); }
            ss += __shfl_xor(ss, 16); ss += __shfl_xor(ss, 32);
            const float rs = __builtin_amdgcn_rsqf(ss * (1.0f / 96.0f) + EPS);
            bf16_t* kr = K + ((size_t)hl * MKP + r) * 96;
#pragma unroll
            for (int bj = 0; bj < 2; ++bj) st_bf8(kr + 32 * bj + 8 * fq, acc[ai][bj][m][0] * g[bj][0] * rs, acc[ai][bj][m][1] * g[bj][1] * rs);
            u32x4 w; r0 = r0 * gr0 * rs; r1 = r1 * gr1 * rs; w.x = pk2(r0[0], r0[1]); w.y = pk2(r0[2], r0[3]); w.z = pk2(r1[0], r1[1]); w.w = pk2(r1[2], r1[3]);
            *(u32x4*)(kr + 64 + 8 * fq) = w; }
    }
};
struct EpiVt {
    static constexpr bool PERMB = true;
    bf16_t* O;
    DI void operator()(const Acc& acc, const Unit& u, int wr, int wc, int fr_, int fq_) const {
        const int lane_ = fresh_lane(), fr = lane_ & 15, fq = lane_ >> 4;
        const int row0 = u.pm * 256 + wr * 64 + fr, col0 = u.pn * 256 + wc * 32 + 8 * fq;
#pragma unroll
        for (int bj = 0; bj < 2; ++bj) { const int r = col0 + bj * 128; int tile, j;
            if (r < MP) { const int b = r / LP, i = r - b * LP; tile = b * 65 + (i >> 6); j = i & 63; }
            else { const int r2 = r - MP, b = r2 / LSK, i = r2 - b * LSK; tile = 16 * 65 + b * 33 + (i >> 6); j = i & 63; }
#pragma unroll
            EPI_ROWS(ai, m) { const int row = row0 + ai * 128 + m * 16, hl = row >> 6, d = row & 63;
                st_bf8(O + ((((size_t)hl * NVT + tile) * 64 + d) << 6) + j, acc[ai][bj][m][0], acc[ai][bj][m][1]); } }
    }
};
template <class Epi> DI void run_gemm(LAS unsigned char* lds, const bf16_t* A, const bf16_t* Bt, int Mr, int N, int K, const Epi& E, int coff) {
    const int vb = (int)*(volatile LAS unsigned*)(lds + 131072 + 8);
    pg8::Gemm g{A, Bt, Mr, N, K, K}; pg8::StaticOrder S; S.init(Mr, N, (int)gridDim.x, (int)((vb + coff) % gridDim.x));
    pg8::gemm_phase<Epi, pg8::StaticOrder>(lds, g, S, E);
}

template <int KIND> DI float wval(const float* src, const float* qan, int np, int kp) {
    if (KIND == 0 || KIND == 2 || KIND == 3 || KIND == 4 || KIND == 6) { const int r = np & 31; np = (np & ~31) | (8 * ((r >> 2) & 3) + 4 * (r >> 4) + (r & 3)); }
    if (KIND == 6) return src[(size_t)kp * 1024 + np];
    if (KIND == 0) { const int T = np >> 8, e = np & 127; return src[(size_t)kp * FF + 128 * T + e] * (((np >> 7) & 1) ? 0.6931471805599453f : 1.4426950408889634f); }
    if (KIND == 1) return src[(size_t)kp * 1024 + np];
    if (KIND == 2) { const int T = np >> 8, r = np & 255; int col;
        if (T < 4) col = np;
        else if (T < 12) col = ((r >> 7) ? 2048 : 1024) + 128 * (T - 4) + (r & 127);
        else if (T < 16) col = 3616 + 256 * (T - 12) + r;
        else if (T < 20) col = 4640 + 256 * (T - 16) + r;
        else if (T == 20) col = 3072 + r;
        else if (T == 21) col = r < 128 ? 3072 + 256 + r : 3456 + (r - 128);
        else col = r < 32 ? 3584 + r : -1;
        return col < 0 ? 0.f : src[(size_t)kp * 5664 + col] * ((T >= 12 && T < 20) ? 1.4426950408889634f : 1.0f); }
    if (KIND == 3) return src[(size_t)kp * 1536 + np] * qan[kp];
    if (KIND == 4) { const int hh = np >> 9, pn = (np >> 8) & 1, bj = (np >> 7) & 1, wc = (np >> 5) & 3, e = np & 31; const int head = 8 * hh + 4 * pn + wc, dim = 32 * bj + e;
        return kp < 128 ? src[(size_t)kp * 2048 + head * 128 + dim] : 0.f; }
    return kp < 128 ? src[(size_t)kp * 2048 + (np >> 6) * 128 + 64 + (np & 63)] : 0.f;
}
template <int KIND> DI void wconv(const float* src, const float* src2, const float* qan, bf16_t* dst, int NP, int KP, LAS float* scr) {
    const int tid = threadIdx.x, nkt = KP >> 6, ntiles = (NP >> 6) * nkt;
    float cur[8], nxt[8];
#define WC_LOAD(dstv, tile_) do { const int ntl_ = (tile_) / nkt, kt_ = (tile_) - ntl_ * nkt, n0_ = ntl_ * 64, k0_ = kt_ * 64; \
        const float* sp_ = src; if (KIND == 0 && ((n0_ >> 7) & 1)) sp_ = src2; \
        _Pragma("unroll") for (int i = 0; i < 8; ++i) dstv[i] = wval<KIND>(sp_, qan, n0_ + (tid & 63), k0_ + (tid >> 6) + 8 * i); } while (0)
    int tile = blockIdx.x;
    if (tile < ntiles) WC_LOAD(cur, tile);
    for (; tile < ntiles; tile += gridDim.x) {
        const int ntl = tile / nkt, kt = tile - ntl * nkt, n0 = ntl * 64, k0 = kt * 64;
        const bool more = tile + (int)gridDim.x < ntiles;
        if (more) WC_LOAD(nxt, tile + (int)gridDim.x);
#pragma unroll
        for (int i = 0; i < 8; ++i) { const int kk = (tid >> 6) + 8 * i, nn = tid & 63; scr[kk * 65 + nn] = cur[i]; }
        __syncthreads();
#pragma unroll
        for (int i = 0; i < 4; ++i) { const int nn = (tid >> 5) + 16 * i, kk = (tid & 31) * 2; *(unsigned*)(dst + (size_t)(n0 + nn) * KP + k0 + kk) = pk2(scr[kk * 65 + nn], scr[(kk + 1) * 65 + nn]); }
        __syncthreads();
#pragma unroll
        for (int i = 0; i < 8; ++i) cur[i] = nxt[i];
    }
#undef WC_LOAD
}
DI void tail_sum(const float* P, int r, int S, int lane, f32x4 (&t)[4]) {
    const int pp = (r - M_MAIN) >> 8, rr = r & 255;
#pragma unroll
    for (int j = 0; j < 4; ++j) t[j] = (f32x4){0.f, 0.f, 0.f, 0.f};
    for (int s_ = 0; s_ < S; ++s_) {
#pragma unroll
        for (int j = 0; j < 4; ++j) t[j] += *(const f32x4*)(P + (size_t)((s_ * NTAILP + pp) * 4 + j) * 65536 + (size_t)rr * 256 + 4 * lane); }
}
DI void norm_rows(const Params& p, int from_src0, const float* gain, bf16_t* H, int tailS, float tscale, int tail_src0) {
    const int lane = threadIdx.x & 63, gw = blockIdx.x * 8 + (threadIdx.x >> 6), NGW = gridDim.x * 8;
    const float* P = (const float*)(p.ws + OFF_ATT);
    f32x4 gv[4];
#pragma unroll
    for (int j = 0; j < 4; ++j) gv[j] = *(const f32x4*)(gain + 4 * (lane + 64 * j));
    for (int r0 = gw; r0 < M; r0 += 4 * NGW) {
        f32x4 v[4][4]; float ss[4];
#pragma unroll
        for (int k = 0; k < 4; ++k) { const int r = r0 + k * NGW; const int rc = r < M ? r : r0; const bool tl = tailS > 0 && r >= M_MAIN && r < M; const float* x = (from_src0 || (tl && tail_src0)) ? xrow_src0(p, rc) : xrow_dst(p, rc);
#pragma unroll
            for (int j = 0; j < 4; ++j) v[k][j] = *(const f32x4*)(x + 4 * (lane + 64 * j));
            if (tl) { f32x4 t[4]; tail_sum(P, r, tailS, lane, t); float* xd = xrow_dst(p, r);
#pragma unroll
                for (int j = 0; j < 4; ++j) { v[k][j] += tscale * t[j]; *(f32x4*)(xd + 4 * (lane + 64 * j)) = v[k][j]; } } }
#pragma unroll
        for (int k = 0; k < 4; ++k) { float a = 0.f;
#pragma unroll
            for (int j = 0; j < 4; ++j) a += (v[k][j][0] * v[k][j][0] + v[k][j][1] * v[k][j][1]) + (v[k][j][2] * v[k][j][2] + v[k][j][3] * v[k][j][3]);
            ss[k] = a; }
#pragma unroll
        for (int o = 1; o < 64; o <<= 1) {
#pragma unroll
            for (int k = 0; k < 4; ++k) ss[k] += __shfl_xor(ss[k], o); }
#pragma unroll
        for (int k = 0; k < 4; ++k) { const int r = r0 + k * NGW; if (r < M) { const float rs = __builtin_amdgcn_rsqf(ss[k] * (1.0f / 1024.0f) + EPS);
#pragma unroll
            for (int j = 0; j < 4; ++j) st_bf4(H + (size_t)r * 1024 + 4 * (lane + 64 * j), v[k][j] * gv[j] * rs); } }
    }
}
DI void phase_prep(const Params& p, LAS unsigned char* lds) {
    unsigned char* ws = p.ws;
    LAS float* scr = (LAS float*)lds;
    wconv<0>(p.in[I_F1G], p.in[I_F1U], nullptr, (bf16_t*)(ws + OFF_W1GU), 5632, 1024, scr);
    wconv<6>(p.in[I_F1D], nullptr, nullptr, (bf16_t*)(ws + OFF_W1D), 1024, 2816, scr);
    wconv<2>(p.in[I_WIN], nullptr, nullptr, (bf16_t*)(ws + OFF_WIN), NIN, 1024, scr);
    wconv<3>(p.in[I_WUQ], nullptr, p.in[I_QAN], (bf16_t*)(ws + OFF_WUQ), 1536, 384, scr);
    wconv<4>(p.in[I_WUKV], nullptr, nullptr, (bf16_t*)(ws + OFF_WK), 1024, 128, scr);
    wconv<5>(p.in[I_WUKV], nullptr, nullptr, (bf16_t*)(ws + OFF_WVT), 1024, 128, scr);
    wconv<6>(p.in[I_WCO], nullptr, nullptr, (bf16_t*)(ws + OFF_WCO), 1024, 1024, scr);
    wconv<6>(p.in[I_WMO], nullptr, nullptr, (bf16_t*)(ws + OFF_WMO), 1024, 1024, scr);
    wconv<6>(p.in[I_WOUT], nullptr, nullptr, (bf16_t*)(ws + OFF_WOUT), 1024, 1024, scr);
    wconv<0>(p.in[I_F2G], p.in[I_F2U], nullptr, (bf16_t*)(ws + OFF_W2GU), 5632, 1024, scr);
    wconv<6>(p.in[I_F2D], nullptr, nullptr, (bf16_t*)(ws + OFF_W2D), 1024, 2816, scr);
    f32x2* rot = (f32x2*)(ws + OFF_ROT);
    for (int e = blockIdx.x * 512 + threadIdx.x; e < LP * 16; e += gridDim.x * 512) {
        const int pos = e >> 4, i = e & 15; double inv = 1.0;
        for (int k = 0; k < i; ++k) inv *= 0.56234132519034908;
        const double ang = (double)pos * inv; const double n = rint(ang * 0.15915494309189535);
        double r = fma(-n, 6.283185307179586, ang); r = fma(-n, 2.4492935982947064e-16, r);
        const double r2 = r * r; double tc = 1.0, sc = 1.0, tsn = r, ssn = r;
        for (int k = 1; k <= 14; ++k) { tc *= -r2 / (double)((2 * k - 1) * (2 * k)); sc += tc; tsn *= -r2 / (double)((2 * k) * (2 * k + 1)); ssn += tsn; }
        rot[e] = (f32x2){(float)sc, (float)ssn};
    }
    norm_rows(p, 1, p.in[I_F1N], (bf16_t*)(ws + OFF_H), 0, 0.f, 0);
}

DI void phase_lat_conv(const Params& p) {
    unsigned char* ws = p.ws;
    const int lane = threadIdx.x & 63, gw = blockIdx.x * 8 + (threadIdx.x >> 6), NGW = gridDim.x * 8;
    const float* ZL = (const float*)(ws + OFF_ZL); const bf16_t* ZQ = (const bf16_t*)(ws + OFF_ZQ);
    bf16_t* CKV = (bf16_t*)(ws + OFF_CKV); bf16_t* KPE = (bf16_t*)(ws + OFF_KPE); float* RQ = (float*)(ws + OFF_RQ);
    const f32x2* rot = (const f32x2*)(ws + OFF_ROT);
    const f32x4 gkv = *(const f32x4*)(p.in[I_KVAN] + 4 * (lane & 31));
    for (int r0 = gw; r0 < M; r0 += 4 * NGW) {
        f32x4 v[4]; float x1[4], x2[4]; f32x2 cs[4]; u32x4 zq[4]; int rr[4];
#pragma unroll
        for (int k = 0; k < 4; ++k) { const int r = r0 + k * NGW < M ? r0 + k * NGW : r0; rr[k] = r;
            const int pos = r < MP ? r % LP : 16 + PAST + ((r - MP) & 31);
            v[k] = (f32x4){0.f, 0.f, 0.f, 0.f}; x1[k] = 0.f; x2[k] = 0.f; cs[k] = (f32x2){0.f, 0.f}; zq[k] = (u32x4){0u, 0u, 0u, 0u};
            if (lane < 32) v[k] = *(const f32x4*)(ZL + (size_t)r * 160 + 4 * lane);
            if (lane < 16) { x1[k] = ZL[(size_t)r * 160 + 128 + lane]; x2[k] = ZL[(size_t)r * 160 + 144 + lane]; cs[k] = rot[pos * 16 + lane]; }
            if (lane < 48) zq[k] = *(const u32x4*)(ZQ + (size_t)r * 384 + 8 * lane); }
        float ss[4], sq[4];
#pragma unroll
        for (int k = 0; k < 4; ++k) { ss[k] = (v[k][0] * v[k][0] + v[k][1] * v[k][1]) + (v[k][2] * v[k][2] + v[k][3] * v[k][3]); const u32x4 z = zq[k];
            const float a0 = bflo(z.x), a1 = bfhi(z.x), a2 = bflo(z.y), a3 = bfhi(z.y), a4 = bflo(z.z), a5 = bfhi(z.z), a6 = bflo(z.w), a7 = bfhi(z.w);
            sq[k] = (a0 * a0 + a1 * a1) + (a2 * a2 + a3 * a3) + (a4 * a4 + a5 * a5) + (a6 * a6 + a7 * a7); }
#pragma unroll
        for (int o = 1; o < 64; o <<= 1) {
#pragma unroll
            for (int k = 0; k < 4; ++k) { ss[k] += __shfl_xor(ss[k], o); sq[k] += __shfl_xor(sq[k], o); } }
#pragma unroll
        for (int k = 0; k < 4; ++k) { const int r = rr[k]; if (r0 + k * NGW < M) {
            int keyrow; float *okv, *okr;
            if (r < MP) { keyrow = r; okv = p.out + OUT_KVP + (size_t)r * 128; okr = p.out + OUT_KRP + (size_t)r * 32; }
            else { const int rs_ = r - MP, b = rs_ >> 5, j = rs_ & 31; keyrow = MP + b * LSK + PAST + j; okv = p.out + OUT_KVS + (size_t)rs_ * 128; okr = p.out + OUT_KRS + (size_t)rs_ * 32; }
            const float rs = __builtin_amdgcn_rsqf(ss[k] * (1.0f / 128.0f) + EPS);
            const f32x4 vn = v[k] * gkv * rs;
            if (lane < 32) { *(f32x4*)(okv + 4 * lane) = vn; st_bf4(CKV + (size_t)keyrow * 128 + 4 * lane, vn); }
            if (lane < 16) { const float o1 = x1[k] * cs[k].x - x2[k] * cs[k].y, o2 = x2[k] * cs[k].x + x1[k] * cs[k].y; okr[lane] = o1; okr[16 + lane] = o2;
                KPE[(size_t)keyrow * 32 + lane] = (bf16_t)(pk2(o1, 0.f) & 0xffffu); KPE[(size_t)keyrow * 32 + 16 + lane] = (bf16_t)(pk2(o2, 0.f) & 0xffffu); }
            if (lane == 0) RQ[r] = __builtin_amdgcn_rsqf(sq[k] * (1.0f / 384.0f) + EPS); } }
    }
    for (int c0_ = gw; c0_ < NB * PAST; c0_ += 4 * NGW) {
        f32x4 a[4], c[4];
#pragma unroll
        for (int k = 0; k < 4; ++k) { const int cr = c0_ + k * NGW < NB * PAST ? c0_ + k * NGW : c0_; a[k] = (f32x4){0.f, 0.f, 0.f, 0.f}; c[k] = a[k];
            if (lane < 32) a[k] = *(const f32x4*)(p.in[I_CKV] + (size_t)cr * 128 + 4 * lane);
            if (lane < 8) c[k] = *(const f32x4*)(p.in[I_CKR] + (size_t)cr * 32 + 4 * lane); }
#pragma unroll
        for (int k = 0; k < 4; ++k) { const int cr = c0_ + k * NGW; if (cr < NB * PAST) { const int b = cr >> 11, j = cr & 2047, keyrow = MP + b * LSK + j;
            if (lane < 32) st_bf4(CKV + (size_t)keyrow * 128 + 4 * lane, a[k]);
            if (lane < 8) st_bf4(KPE + (size_t)keyrow * 32 + 4 * lane, c[k]); } }
    }
    {
        bf16_t* BG = (bf16_t*)(ws + OFF_BG); const bf16_t* CIN = (const bf16_t*)(ws + OFF_CIN);
        const int gt = blockIdx.x * 512 + threadIdx.x, NT = gridDim.x * 512, c8 = gt & 127, c0 = c8 * 8;
        float w0[8], w1[8], w2[8];
#pragma unroll
        for (int j = 0; j < 8; ++j) { w0[j] = p.in[I_CONVW][c0 + j]; w1[j] = p.in[I_CONVW][1024 + c0 + j]; w2[j] = p.in[I_CONVW][2048 + c0 + j]; }
        const int nchunk = NT >> 7, RC = (M + nchunk - 1) / nchunk, rbeg = (gt >> 7) * RC, rend = rbeg + RC < M ? rbeg + RC : M;
#define CV_UNPK(dst, ZV) do { const u32x4 zv_ = (ZV); dst[0] = bflo(zv_.x); dst[1] = bfhi(zv_.x); dst[2] = bflo(zv_.y); dst[3] = bfhi(zv_.y); dst[4] = bflo(zv_.z); dst[5] = bfhi(zv_.z); dst[6] = bflo(zv_.w); dst[7] = bfhi(zv_.w); } while (0)
        float xm1[8], xm2[8];
#pragma unroll
        for (int j = 0; j < 8; ++j) { xm1[j] = 0.f; xm2[j] = 0.f; }
        if (rbeg < rend) {
            if (rbeg >= 1) { const u32x4 z = *(const u32x4*)(CIN + (size_t)(rbeg - 1) * 1024 + c0); CV_UNPK(xm1, z); }
            if (rbeg >= 2) { const u32x4 z = *(const u32x4*)(CIN + (size_t)(rbeg - 2) * 1024 + c0); CV_UNPK(xm2, z); }
        }
        for (int r4 = rbeg; r4 < rend; r4 += 4) {
            u32x4 cz[4], bz[4];
#pragma unroll
            for (int k = 0; k < 4; ++k) { const int r = r4 + k < rend ? r4 + k : rend - 1; cz[k] = *(const u32x4*)(CIN + (size_t)r * 1024 + c0); bz[k] = *(const u32x4*)(BG + (size_t)r * 1024 + c0); }
#pragma unroll
            for (int k = 0; k < 4; ++k) { const int r = r4 + k; if (r < rend) {
                float x0[8], bg[8]; CV_UNPK(x0, cz[k]); CV_UNPK(bg, bz[k]);
                int i, bb; const bool prompt = r < MP;
                if (prompt) { bb = r / LP; i = r - bb * LP; } else { bb = (r - MP) >> 5; i = (r - MP) & 31; }
                if (i == 0) {
#pragma unroll
                    for (int j = 0; j < 8; ++j) { xm1[j] = prompt ? 0.f : p.in[I_CCONV][((size_t)bb * 2 + 1) * 1024 + c0 + j]; xm2[j] = prompt ? 0.f : p.in[I_CCONV][((size_t)bb * 2) * 1024 + c0 + j]; } }
                else if (i == 1) {
#pragma unroll
                    for (int j = 0; j < 8; ++j) xm2[j] = prompt ? 0.f : p.in[I_CCONV][((size_t)bb * 2 + 1) * 1024 + c0 + j]; }
                float o[8];
#pragma unroll
                for (int j = 0; j < 8; ++j) o[j] = bg[j] * (w0[j] * xm2[j] + w1[j] * xm1[j] + w2[j] * x0[j]);
                u32x4 w; w.x = pk2(o[0], o[1]); w.y = pk2(o[2], o[3]); w.z = pk2(o[4], o[5]); w.w = pk2(o[6], o[7]);
                *(u32x4*)(BG + (size_t)r * 1024 + c0) = w;
                const int L = prompt ? LP : DS;
                if (i >= L - 2) { float* op = p.out + (prompt ? OUT_NCP : OUT_NCS) + ((size_t)bb * 2 + (i - (L - 2))) * 1024 + c0;
                    *(f32x4*)op = (f32x4){x0[0], x0[1], x0[2], x0[3]}; *(f32x4*)(op + 4) = (f32x4){x0[4], x0[5], x0[6], x0[7]}; }
#pragma unroll
                for (int j = 0; j < 8; ++j) { xm2[j] = xm1[j]; xm1[j] = x0[j]; } } }
        }
#undef CV_UNPK
    }
}

#define MFMA32(a, b, c) __builtin_amdgcn_mfma_f32_32x32x16_bf16((a), (b), (c), 0, 0, 0)
constexpr int KROW_B = 208, VROW_B = 136, KBUF_B = 64 * KROW_B, VBUF_B = 64 * VROW_B, ABUF_B = KBUF_B + VBUF_B;
template <bool FAST> DI void attn_body(const Params& p, LAS unsigned char* lds, int hh, float m0) {
    unsigned char* ws = p.ws;
    const int tid = threadIdx.x, wid = __builtin_amdgcn_readfirstlane(tid >> 6), lane = tid & 63, q = lane & 31, hl = lane >> 5;
    const bf16_t* QR = (const bf16_t*)(ws + OFF_QR); const bf16_t* KH = (const bf16_t*)(ws + OFF_KH); const bf16_t* VT = (const bf16_t*)(ws + OFF_VT);
    bf16_t* ATT = (bf16_t*)(ws + OFF_ATT); const f32x2* rot = (const f32x2*)(ws + OFF_ROT); const float* qg = p.in[I_QN];
    const int kp_row = tid / 12, kp_c = tid - kp_row * 12, kp2 = 512 + tid, kp2_row = kp2 / 12, kp2_c = kp2 - kp2_row * 12;
    const int v_row = tid >> 3, v_c = tid & 7;
    const int vbk = (int)*(volatile LAS unsigned*)(lds + 131072 + 8);
    for (int ii = 0; ii < 9; ++ii) {
        int b, h, kb, vt0, ntile, qrow = -1, nvalid = 0, nk = 0, pos0 = 0, kind, g = 0, idx;
        { const int x = vbk & 7, r = vbk >> 3, grp = r >> 3, j = r & 7;
          if (ii < 8) { kind = 0; idx = x * 16 + (ii >> 1) * 4 + grp; g = (ii & 1) ? j : 15 - j; }
          else if (r < 16) { kind = 1; idx = x * 16 + r; }
          else { kind = 2; idx = x * 16 + (r - 16); } }
        b = idx >> 3; h = idx & 7;
        if (kind == 0) { const int c = 4 * g + (wid >> 1), i0 = 16 + 64 * c + 32 * (wid & 1); qrow = b * LP + i0; nvalid = 32; nk = 64 * c + 80; pos0 = i0; kb = b * LP; vt0 = b * 65; ntile = 4 * g + 5; }
        else if (kind == 1) { kb = MP + b * LSK; vt0 = 16 * 65 + b * 33; ntile = 33;
            if (wid == 0) { qrow = MP + b * DS; nvalid = 32; nk = LSK; pos0 = 16 + PAST; } }
        else { kb = b * LP; vt0 = b * 65; ntile = 1;
            if (wid == 0) { qrow = b * LP; nvalid = 16; nk = 16; pos0 = 0; } }
        const int hg = 8 * hh + h, ntw = (nk + 63) >> 6;
        bf16x8 qf[6];
#pragma unroll
        for (int s = 0; s < 6; ++s) qf[s] = (bf16x8){0, 0, 0, 0, 0, 0, 0, 0};
        if (qrow >= 0) {
            const bf16_t* qp = QR + (size_t)(qrow + q) * 1536 + hg * 96 + 8 * hl;
            float x[6][8]; float ss = 0.f;
#pragma unroll
            for (int s = 0; s < 6; ++s) { const u32x4 z = *(const u32x4*)(qp + 16 * s);
                x[s][0] = bflo(z.x); x[s][1] = bfhi(z.x); x[s][2] = bflo(z.y); x[s][3] = bfhi(z.y); x[s][4] = bflo(z.z); x[s][5] = bfhi(z.z); x[s][6] = bflo(z.w); x[s][7] = bfhi(z.w);
#pragma unroll
                for (int e = 0; e < 8; ++e) ss += x[s][e] * x[s][e]; }
            ss += __shfl_xor(ss, 32);
            const float rs = __builtin_amdgcn_rsqf(ss * (1.0f / 96.0f) + EPS) * (0.10206207261596575f * 1.4426950408889634f);
            const f32x2* rp = rot + (size_t)(pos0 + q) * 16 + 8 * hl;
#pragma unroll
            for (int e = 0; e < 8; ++e) { const f32x2 cs = rp[e]; const float a = x[4][e], bb = x[5][e]; x[4][e] = a * cs.x - bb * cs.y; x[5][e] = bb * cs.x + a * cs.y; }
#pragma unroll
            for (int s = 0; s < 6; ++s) { const f32x4 g0 = *(const f32x4*)(qg + 16 * s + 8 * hl), g1 = *(const f32x4*)(qg + 16 * s + 8 * hl + 4);
                u32x4 w; w.x = pk2(x[s][0] * g0[0] * rs, x[s][1] * g0[1] * rs); w.y = pk2(x[s][2] * g0[2] * rs, x[s][3] * g0[3] * rs);
                w.z = pk2(x[s][4] * g1[0] * rs, x[s][5] * g1[1] * rs); w.w = pk2(x[s][6] * g1[2] * rs, x[s][7] * g1[3] * rs);
                qf[s] = __builtin_bit_cast(bf16x8, w); }
        }
        const bf16_t* kbase = KH + ((size_t)h * MKP + kb) * 96 + tid * 8;
        const bf16_t* vbase = VT + (((size_t)h * NVT + vt0) << 12) + tid * 8;
        u32x4 kr0, kr1 = (u32x4){0, 0, 0, 0}, vr;
        kr0 = *(const u32x4*)(kbase);
        if (tid < 256) kr1 = *(const u32x4*)(kbase + 4096);
        vr = *(const u32x4*)(vbase);
        *(LAS u32x4*)(lds + kp_row * KROW_B + kp_c * 16) = kr0;
        if (tid < 256) *(LAS u32x4*)(lds + kp2_row * KROW_B + kp2_c * 16) = kr1;
        *(LAS u32x2*)(lds + KBUF_B + v_row * VROW_B + v_c * 16) = (u32x2){vr.x, vr.y}; *(LAS u32x2*)(lds + KBUF_B + v_row * VROW_B + v_c * 16 + 8) = (u32x2){vr.z, vr.w};
        __syncthreads();
        float mrun = -1e30f, lrun = 0.f;
        f32x16 o0, o1;
#pragma unroll
        for (int i = 0; i < 16; ++i) { o0[i] = 0.f; o1[i] = 0.f; }
        for (int t = 0; t < ntile; ++t) {
            const bool more = (t + 1 < ntile);
            if (more) { const size_t ko = (size_t)(t + 1) * 6144;
                kr0 = *(const u32x4*)(kbase + ko);
                if (tid < 256) kr1 = *(const u32x4*)(kbase + ko + 4096);
                vr = *(const u32x4*)(vbase + (size_t)(t + 1) * 4096); }
            if (t < ntw) {
                const LAS unsigned char* Kb = lds + (t & 1) * ABUF_B; const LAS unsigned char* Vb = Kb + KBUF_B;
                f32x16 s0, s1;
#pragma unroll
                for (int i = 0; i < 16; ++i) { s0[i] = FAST ? -m0 : 0.f; s1[i] = FAST ? -m0 : 0.f; }
#pragma unroll
                for (int s = 0; s < 6; ++s) {
                    const bf16x8 k0 = *(const LAS bf16x8*)(Kb + q * KROW_B + s * 32 + hl * 16);
                    const bf16x8 k1 = *(const LAS bf16x8*)(Kb + (q + 32) * KROW_B + s * 32 + hl * 16);
                    s0 = MFMA32(k0, qf[s], s0); s1 = MFMA32(k1, qf[s], s1);
                }
                if (64 * (t + 1) > nk) {
#pragma unroll
                    for (int i = 0; i < 16; ++i) { const int key = 64 * t + (i & 3) + 8 * (i >> 2) + 4 * hl; if (key >= nk) s0[i] = -1e30f; if (key + 32 >= nk) s1[i] = -1e30f; }
                }
                float ps = 0.f;
                if (FAST) {
#pragma unroll
                    for (int i = 0; i < 16; ++i) { s0[i] = __builtin_amdgcn_exp2f(s0[i]); s1[i] = __builtin_amdgcn_exp2f(s1[i]); ps += s0[i] + s1[i]; }
                    lrun += ps;
                } else {
                    float mx = fmaxf(s0[0], s1[0]);
#pragma unroll
                    for (int i = 1; i < 16; ++i) mx = fmaxf(mx, fmaxf(s0[i], s1[i]));
                    mx = fmaxf(mx, __shfl_xor(mx, 32));
                    const float mn = fmaxf(mrun, mx), alpha = __builtin_amdgcn_exp2f(mrun - mn); mrun = mn;
#pragma unroll
                    for (int i = 0; i < 16; ++i) { s0[i] = __builtin_amdgcn_exp2f(s0[i] - mn); s1[i] = __builtin_amdgcn_exp2f(s1[i] - mn); ps += s0[i] + s1[i]; }
                    lrun = lrun * alpha + ps;
#pragma unroll
                    for (int i = 0; i < 16; ++i) { o0[i] *= alpha; o1[i] *= alpha; }
                }
#pragma unroll
                for (int kb2 = 0; kb2 < 2; ++kb2)
#pragma unroll
                    for (int s2 = 0; s2 < 2; ++s2) {
                        u32x4 pw;
                        if (kb2 == 0) { pw.x = pk2(s0[8 * s2 + 0], s0[8 * s2 + 1]); pw.y = pk2(s0[8 * s2 + 2], s0[8 * s2 + 3]); pw.z = pk2(s0[8 * s2 + 4], s0[8 * s2 + 5]); pw.w = pk2(s0[8 * s2 + 6], s0[8 * s2 + 7]); }
                        else { pw.x = pk2(s1[8 * s2 + 0], s1[8 * s2 + 1]); pw.y = pk2(s1[8 * s2 + 2], s1[8 * s2 + 3]); pw.z = pk2(s1[8 * s2 + 4], s1[8 * s2 + 5]); pw.w = pk2(s1[8 * s2 + 6], s1[8 * s2 + 7]); }
                        const bf16x8 pf = __builtin_bit_cast(bf16x8, pw);
                        const int kofs = (32 * kb2 + 16 * s2 + 4 * hl) * 2;
                        const u32x2 a0 = *(const LAS u32x2*)(Vb + q * VROW_B + kofs), a1 = *(const LAS u32x2*)(Vb + q * VROW_B + kofs + 16);
                        const u32x2 c0 = *(const LAS u32x2*)(Vb + (q + 32) * VROW_B + kofs), c1 = *(const LAS u32x2*)(Vb + (q + 32) * VROW_B + kofs + 16);
                        o0 = MFMA32(__builtin_bit_cast(bf16x8, ((u32x4){a0.x, a0.y, a1.x, a1.y})), pf, o0);
                        o1 = MFMA32(__builtin_bit_cast(bf16x8, ((u32x4){c0.x, c0.y, c1.x, c1.y})), pf, o1);
                    }
            }
            if (more) { LAS unsigned char* nb = lds + ((t + 1) & 1) * ABUF_B;
                *(LAS u32x4*)(nb + kp_row * KROW_B + kp_c * 16) = kr0;
                if (tid < 256) *(LAS u32x4*)(nb + kp2_row * KROW_B + kp2_c * 16) = kr1;
                *(LAS u32x2*)(nb + KBUF_B + v_row * VROW_B + v_c * 16) = (u32x2){vr.x, vr.y}; *(LAS u32x2*)(nb + KBUF_B + v_row * VROW_B + v_c * 16 + 8) = (u32x2){vr.z, vr.w}; }
            __syncthreads();
        }
        if (qrow >= 0) {
            const float inv = 1.0f / (lrun + __shfl_xor(lrun, 32));
            if (q < nvalid) { bf16_t* op = ATT + (size_t)(qrow + q) * 1024 + hg * 64 + 4 * hl;
#pragma unroll
                for (int ig = 0; ig < 4; ++ig) {
                    st_bf4(op + 8 * ig, (f32x4){o0[4 * ig] * inv, o0[4 * ig + 1] * inv, o0[4 * ig + 2] * inv, o0[4 * ig + 3] * inv});
                    st_bf4(op + 32 + 8 * ig, (f32x4){o1[4 * ig] * inv, o1[4 * ig + 1] * inv, o1[4 * ig + 2] * inv, o1[4 * ig + 3] * inv}); } }
        }
    }
}
DI void load_q(const bf16_t* QR, const f32x2* rot, const float* qg, int qrow, int hg, int pos0, int q, int hl, bf16x8 (&qf)[6]) {
    const bf16_t* qp = QR + (size_t)(qrow + q) * 1536 + hg * 96 + 8 * hl;
    float x[6][8]; float ss = 0.f;
#pragma unroll
    for (int s = 0; s < 6; ++s) { const u32x4 z = *(const u32x4*)(qp + 16 * s);
        x[s][0] = bflo(z.x); x[s][1] = bfhi(z.x); x[s][2] = bflo(z.y); x[s][3] = bfhi(z.y); x[s][4] = bflo(z.z); x[s][5] = bfhi(z.z); x[s][6] = bflo(z.w); x[s][7] = bfhi(z.w);
#pragma unroll
        for (int e = 0; e < 8; ++e) ss += x[s][e] * x[s][e]; }
    ss += __shfl_xor(ss, 32);
    const float rs = __builtin_amdgcn_rsqf(ss * (1.0f / 96.0f) + EPS) * (0.10206207261596575f * 1.4426950408889634f);
    const f32x2* rp = rot + (size_t)(pos0 + q) * 16 + 8 * hl;
#pragma unroll
    for (int e = 0; e < 8; ++e) { const f32x2 cs = rp[e]; const float a = x[4][e], bb = x[5][e]; x[4][e] = a * cs.x - bb * cs.y; x[5][e] = bb * cs.x + a * cs.y; }
#pragma unroll
    for (int s = 0; s < 6; ++s) { const f32x4 g0 = *(const f32x4*)(qg + 16 * s + 8 * hl), g1 = *(const f32x4*)(qg + 16 * s + 8 * hl + 4);
        u32x4 w; w.x = pk2(x[s][0] * g0[0] * rs, x[s][1] * g0[1] * rs); w.y = pk2(x[s][2] * g0[2] * rs, x[s][3] * g0[3] * rs);
        w.z = pk2(x[s][4] * g1[0] * rs, x[s][5] * g1[1] * rs); w.w = pk2(x[s][6] * g1[2] * rs, x[s][7] * g1[3] * rs);
        qf[s] = __builtin_bit_cast(bf16x8, w); }
}
DI void attn_sample(const Params& p, LAS unsigned char* lds, int hh, float m0, int b, int h) {
    unsigned char* ws = p.ws;
    const int tid = threadIdx.x, wid = __builtin_amdgcn_readfirstlane(tid >> 6), lane = tid & 63, q = lane & 31, hl = lane >> 5;
    const bf16_t* KH = (const bf16_t*)(ws + OFF_KH); const bf16_t* VT = (const bf16_t*)(ws + OFF_VT); bf16_t* ATT = (bf16_t*)(ws + OFF_ATT);
    const int kb = MP + b * LSK, vt0 = 16 * 65 + b * 33, qrow = MP + b * DS, hg = 8 * hh + h, nk = LSK;
    bf16x8 qf[6];
    load_q((const bf16_t*)(ws + OFF_QR), (const f32x2*)(ws + OFF_ROT), p.in[I_QN], qrow, hg, 16 + PAST, q, hl, qf);
    f32x16 c0, c1; float lsum = 0.f;
#pragma unroll
    for (int i = 0; i < 16; ++i) { c0[i] = 0.f; c1[i] = 0.f; }
    for (int t = wid; t < 33; t += 8) {
        const bf16_t* kp = KH + ((size_t)h * MKP + kb + 64 * t + q) * 96 + 8 * hl;
        const bf16_t* vp = VT + (((size_t)h * NVT + vt0 + t) << 12) + q * 64 + 4 * hl;
        f32x16 x0, x1;
#pragma unroll
        for (int i = 0; i < 16; ++i) { x0[i] = -m0; x1[i] = -m0; }
        { bf16x8 k0[6];
#pragma unroll
          for (int s_ = 0; s_ < 6; ++s_) k0[s_] = *(const bf16x8*)(kp + 16 * s_);
#pragma unroll
          for (int s_ = 0; s_ < 6; ++s_) x0 = MFMA32(k0[s_], qf[s_], x0); }
        { bf16x8 k1[6];
#pragma unroll
          for (int s_ = 0; s_ < 6; ++s_) k1[s_] = *(const bf16x8*)(kp + 32 * 96 + 16 * s_);
#pragma unroll
          for (int s_ = 0; s_ < 6; ++s_) x1 = MFMA32(k1[s_], qf[s_], x1); }
        u32x2 va[4][2], vc[4][2];
#pragma unroll
        for (int f_ = 0; f_ < 4; ++f_) { va[f_][0] = *(const u32x2*)(vp + 16 * f_); va[f_][1] = *(const u32x2*)(vp + 16 * f_ + 8);
            vc[f_][0] = *(const u32x2*)(vp + 32 * 64 + 16 * f_); vc[f_][1] = *(const u32x2*)(vp + 32 * 64 + 16 * f_ + 8); }
        if (64 * (t + 1) > nk) {
#pragma unroll
            for (int i = 0; i < 16; ++i) { const int key = 64 * t + (i & 3) + 8 * (i >> 2) + 4 * hl; if (key >= nk) x0[i] = -1e30f; if (key + 32 >= nk) x1[i] = -1e30f; } }
        float ps = 0.f;
#pragma unroll
        for (int i = 0; i < 16; ++i) { x0[i] = __builtin_amdgcn_exp2f(x0[i]); x1[i] = __builtin_amdgcn_exp2f(x1[i]); ps += x0[i] + x1[i]; }
        lsum += ps;
#pragma unroll
        for (int s2 = 0; s2 < 2; ++s2) { u32x4 pw;
            pw.x = pk2(x0[8 * s2 + 0], x0[8 * s2 + 1]); pw.y = pk2(x0[8 * s2 + 2], x0[8 * s2 + 3]); pw.z = pk2(x0[8 * s2 + 4], x0[8 * s2 + 5]); pw.w = pk2(x0[8 * s2 + 6], x0[8 * s2 + 7]);
            const bf16x8 p0 = __builtin_bit_cast(bf16x8, pw);
            pw.x = pk2(x1[8 * s2 + 0], x1[8 * s2 + 1]); pw.y = pk2(x1[8 * s2 + 2], x1[8 * s2 + 3]); pw.z = pk2(x1[8 * s2 + 4], x1[8 * s2 + 5]); pw.w = pk2(x1[8 * s2 + 6], x1[8 * s2 + 7]);
            const bf16x8 p1 = __builtin_bit_cast(bf16x8, pw);
            c0 = MFMA32(__builtin_bit_cast(bf16x8, ((u32x4){va[s2][0].x, va[s2][0].y, va[s2][1].x, va[s2][1].y})), p0, c0);
            c1 = MFMA32(__builtin_bit_cast(bf16x8, ((u32x4){vc[s2][0].x, vc[s2][0].y, vc[s2][1].x, vc[s2][1].y})), p0, c1);
            c0 = MFMA32(__builtin_bit_cast(bf16x8, ((u32x4){va[2 + s2][0].x, va[2 + s2][0].y, va[2 + s2][1].x, va[2 + s2][1].y})), p1, c0);
            c1 = MFMA32(__builtin_bit_cast(bf16x8, ((u32x4){vc[2 + s2][0].x, vc[2 + s2][0].y, vc[2 + s2][1].x, vc[2 + s2][1].y})), p1, c1); }
    }
    LAS float* red = (LAS float*)lds;
#pragma unroll
    for (int i = 0; i < 16; ++i) { red[(wid * 33 + i) * 64 + lane] = c0[i]; red[(wid * 33 + 16 + i) * 64 + lane] = c1[i]; }
    red[(wid * 33 + 32) * 64 + lane] = lsum;
    asm volatile("s_waitcnt lgkmcnt(0)" ::: "memory"); __builtin_amdgcn_s_barrier(); asm volatile("" ::: "memory");
    if (wid == 0) {
#pragma unroll 1
        for (int w = 1; w < 8; ++w) {
#pragma unroll
            for (int i = 0; i < 16; ++i) { c0[i] += red[(w * 33 + i) * 64 + lane]; c1[i] += red[(w * 33 + 16 + i) * 64 + lane]; }
            lsum += red[(w * 33 + 32) * 64 + lane]; }
        const float inv = 1.0f / (lsum + __shfl_xor(lsum, 32));
        bf16_t* op = ATT + (size_t)(qrow + q) * 1024 + hg * 64 + 4 * hl;
#pragma unroll
        for (int ig = 0; ig < 4; ++ig) {
            st_bf4(op + 8 * ig, (f32x4){c0[4 * ig] * inv, c0[4 * ig + 1] * inv, c0[4 * ig + 2] * inv, c0[4 * ig + 3] * inv});
            st_bf4(op + 32 + 8 * ig, (f32x4){c1[4 * ig] * inv, c1[4 * ig + 1] * inv, c1[4 * ig + 2] * inv, c1[4 * ig + 3] * inv}); }
    }
    asm volatile("s_waitcnt lgkmcnt(0)" ::: "memory"); __builtin_amdgcn_s_barrier(); asm volatile("" ::: "memory");
}
DI void attn_pp(const Params& p, LAS unsigned char* lds, int hh, float m0) {
    unsigned char* ws = p.ws;
    const int tid = threadIdx.x, wid = __builtin_amdgcn_readfirstlane(tid >> 6), lane = tid & 63, q = lane & 31, hl = lane >> 5;
    const bool grpB = wid >= 4;
    const bf16_t* QR = (const bf16_t*)(ws + OFF_QR); const bf16_t* KH = (const bf16_t*)(ws + OFF_KH); const bf16_t* VT = (const bf16_t*)(ws + OFF_VT);
    bf16_t* ATT = (bf16_t*)(ws + OFF_ATT); const f32x2* rot = (const f32x2*)(ws + OFF_ROT); const float* qg = p.in[I_QN];
    const int kp_row = tid / 12, kp_c = tid - kp_row * 12, kp2 = 512 + tid, kp2_row = kp2 / 12, kp2_c = kp2 - kp2_row * 12;
    const int v_row = tid >> 3, v_c = tid & 7;
#define APP_BAR() do { asm volatile("s_waitcnt lgkmcnt(0)" ::: "memory"); __builtin_amdgcn_s_barrier(); asm volatile("" ::: "memory"); } while (0)
    const int vbk = (int)*(volatile LAS unsigned*)(lds + 131072 + 8);
    for (int ii = 0; ii < 9; ++ii) {
        int b, h, kb, vt0, ntile, qrow = -1, nvalid = 0, nk = 0, pos0 = 0, kind, g = 0, idx;
        { const int x = vbk & 7, r = vbk >> 3, grp = r >> 3, j = r & 7;
          if (ii < 8) { kind = 0; idx = x * 16 + (ii >> 1) * 4 + grp; g = (ii & 1) ? j : 15 - j; }
          else if (r < 16) { kind = 1; idx = x * 16 + r; }
          else { kind = 2; idx = x * 16 + (r - 16); } }
        if (kind == 1) { attn_sample(p, lds, hh, m0, idx >> 3, idx & 7); continue; }
        b = idx >> 3; h = idx & 7;
        if (kind == 0) { const int c = 4 * g + (wid >> 1), i0 = 16 + 64 * c + 32 * (wid & 1); qrow = b * LP + i0; nvalid = 32; nk = 64 * c + 80; pos0 = i0; kb = b * LP; vt0 = b * 65; ntile = 4 * g + 5; }
        else if (kind == 1) { kb = MP + b * LSK; vt0 = 16 * 65 + b * 33; ntile = 33;
            if (wid == 0) { qrow = MP + b * DS; nvalid = 32; nk = LSK; pos0 = 16 + PAST; } }
        else { kb = b * LP; vt0 = b * 65; ntile = 1;
            if (wid == 0) { qrow = b * LP; nvalid = 16; nk = 16; pos0 = 0; } }
        const int hg = 8 * hh + h, ntw = qrow >= 0 ? (nk + 63) >> 6 : 0;
        const bf16_t* kbase = KH + ((size_t)h * MKP + kb) * 96 + tid * 8;
        const bf16_t* vbase = VT + (((size_t)h * NVT + vt0) << 12) + tid * 8;
        u32x4 ka0 = (u32x4){0, 0, 0, 0}, ka1 = ka0, va = ka0, kb0 = ka0, kb1 = ka0, vb = ka0;
#define APP_LOAD(K0, K1, V, tK, tV) do { if ((tK) < ntile) { const size_t ko_ = (size_t)(tK) * 6144; K0 = *(const u32x4*)(kbase + ko_); \
            if (tid < 256) K1 = *(const u32x4*)(kbase + ko_ + 4096); } if ((tV) < ntile) V = *(const u32x4*)(vbase + (size_t)(tV) * 4096); } while (0)
#define APP_WRITE(K0, K1, V, tK, tV) do { if ((tK) < ntile) { LAS unsigned char* kd_ = lds + ((tK) & 1) * ABUF_B; *(LAS u32x4*)(kd_ + kp_row * KROW_B + kp_c * 16) = K0; \
            if (tid < 256) *(LAS u32x4*)(kd_ + kp2_row * KROW_B + kp2_c * 16) = K1; } \
            if ((tV) < ntile) { LAS unsigned char* vd_ = lds + ((tV) & 1) * ABUF_B + KBUF_B + v_row * VROW_B + v_c * 16; *(LAS u32x2*)vd_ = (u32x2){V.x, V.y}; *(LAS u32x2*)(vd_ + 8) = (u32x2){V.z, V.w}; } } while (0)
        APP_LOAD(ka0, ka1, va, 0, ntile);
        APP_LOAD(kb0, kb1, vb, 1, 0);
        bf16x8 qf[6];
#pragma unroll
        for (int s = 0; s < 6; ++s) qf[s] = (bf16x8){0, 0, 0, 0, 0, 0, 0, 0};
        if (qrow >= 0) {
            const bf16_t* qp = QR + (size_t)(qrow + q) * 1536 + hg * 96 + 8 * hl;
            float x[6][8]; float ss = 0.f;
#pragma unroll
            for (int s = 0; s < 6; ++s) { const u32x4 z = *(const u32x4*)(qp + 16 * s);
                x[s][0] = bflo(z.x); x[s][1] = bfhi(z.x); x[s][2] = bflo(z.y); x[s][3] = bfhi(z.y); x[s][4] = bflo(z.z); x[s][5] = bfhi(z.z); x[s][6] = bflo(z.w); x[s][7] = bfhi(z.w);
#pragma unroll
                for (int e = 0; e < 8; ++e) ss += x[s][e] * x[s][e]; }
            ss += __shfl_xor(ss, 32);
            const float rs = __builtin_amdgcn_rsqf(ss * (1.0f / 96.0f) + EPS) * (0.10206207261596575f * 1.4426950408889634f);
            const f32x2* rp = rot + (size_t)(pos0 + q) * 16 + 8 * hl;
#pragma unroll
            for (int e = 0; e < 8; ++e) { const f32x2 cs = rp[e]; const float a = x[4][e], bb = x[5][e]; x[4][e] = a * cs.x - bb * cs.y; x[5][e] = bb * cs.x + a * cs.y; }
#pragma unroll
            for (int s = 0; s < 6; ++s) { const f32x4 g0 = *(const f32x4*)(qg + 16 * s + 8 * hl), g1 = *(const f32x4*)(qg + 16 * s + 8 * hl + 4);
                u32x4 w; w.x = pk2(x[s][0] * g0[0] * rs, x[s][1] * g0[1] * rs); w.y = pk2(x[s][2] * g0[2] * rs, x[s][3] * g0[3] * rs);
                w.z = pk2(x[s][4] * g1[0] * rs, x[s][5] * g1[1] * rs); w.w = pk2(x[s][6] * g1[2] * rs, x[s][7] * g1[3] * rs);
                qf[s] = __builtin_bit_cast(bf16x8, w); }
        }
        APP_WRITE(ka0, ka1, va, 0, ntile);
        APP_LOAD(ka0, ka1, va, 2, 1);
        APP_BAR();
        if (grpB) APP_BAR();
        float lrun = 0.f;
        f32x16 o0, o1, s0, s1, cinit;
#pragma unroll
        for (int i = 0; i < 16; ++i) cinit[i] = -m0;
        bf16x8 pf[4];
#pragma unroll
        for (int i = 0; i < 16; ++i) { o0[i] = 0.f; o1[i] = 0.f; s0[i] = 0.f; s1[i] = 0.f; }
#pragma unroll
        for (int i = 0; i < 4; ++i) pf[i] = (bf16x8){0, 0, 0, 0, 0, 0, 0, 0};
#define APP_Z(tt) do { const LAS unsigned char* Vb = lds + ((tt) & 1) * ABUF_B + KBUF_B + q * VROW_B + 8 * hl; \
            u32x2 va_[4][2], vc_[4][2]; \
            _Pragma("unroll") for (int f = 0; f < 4; ++f) { va_[f][0] = *(const LAS u32x2*)(Vb + f * 32); va_[f][1] = *(const LAS u32x2*)(Vb + f * 32 + 16); \
                vc_[f][0] = *(const LAS u32x2*)(Vb + 32 * VROW_B + f * 32); vc_[f][1] = *(const LAS u32x2*)(Vb + 32 * VROW_B + f * 32 + 16); } \
            __builtin_amdgcn_sched_barrier(0); \
            _Pragma("unroll") for (int f = 0; f < 4; ++f) { \
                o0 = MFMA32(__builtin_bit_cast(bf16x8, ((u32x4){va_[f][0].x, va_[f][0].y, va_[f][1].x, va_[f][1].y})), pf[f], o0); \
                o1 = MFMA32(__builtin_bit_cast(bf16x8, ((u32x4){vc_[f][0].x, vc_[f][0].y, vc_[f][1].x, vc_[f][1].y})), pf[f], o1); } } while (0)
#define APP_X(tt) do { const LAS unsigned char* Kb = lds + ((tt) & 1) * ABUF_B + q * KROW_B + hl * 16; \
            { const bf16x8 k0 = *(const LAS bf16x8*)(Kb); const bf16x8 k1 = *(const LAS bf16x8*)(Kb + 32 * KROW_B); \
              s0 = MFMA32(k0, qf[0], cinit); s1 = MFMA32(k1, qf[0], cinit); } \
            _Pragma("unroll") for (int s = 1; s < 6; ++s) { \
                const bf16x8 k0 = *(const LAS bf16x8*)(Kb + s * 32); \
                const bf16x8 k1 = *(const LAS bf16x8*)(Kb + 32 * KROW_B + s * 32); \
                s0 = MFMA32(k0, qf[s], s0); s1 = MFMA32(k1, qf[s], s1); } } while (0)
#define APP_Y(tt) do { if (64 * ((tt) + 1) > nk) { \
                _Pragma("unroll") for (int i = 0; i < 16; ++i) { const int key = 64 * (tt) + (i & 3) + 8 * (i >> 2) + 4 * hl; if (key >= nk) s0[i] = -1e30f; if (key + 32 >= nk) s1[i] = -1e30f; } } \
            float ps = 0.f; \
            _Pragma("unroll") for (int i = 0; i < 16; ++i) { s0[i] = __builtin_amdgcn_exp2f(s0[i]); s1[i] = __builtin_amdgcn_exp2f(s1[i]); ps += s0[i] + s1[i]; } \
            lrun += ps; \
            _Pragma("unroll") for (int s2 = 0; s2 < 2; ++s2) { u32x4 pw; \
                pw.x = pk2(s0[8 * s2 + 0], s0[8 * s2 + 1]); pw.y = pk2(s0[8 * s2 + 2], s0[8 * s2 + 3]); pw.z = pk2(s0[8 * s2 + 4], s0[8 * s2 + 5]); pw.w = pk2(s0[8 * s2 + 6], s0[8 * s2 + 7]); \
                pf[s2] = __builtin_bit_cast(bf16x8, pw); \
                pw.x = pk2(s1[8 * s2 + 0], s1[8 * s2 + 1]); pw.y = pk2(s1[8 * s2 + 2], s1[8 * s2 + 3]); pw.z = pk2(s1[8 * s2 + 4], s1[8 * s2 + 5]); pw.w = pk2(s1[8 * s2 + 6], s1[8 * s2 + 7]); \
                pf[2 + s2] = __builtin_bit_cast(bf16x8, pw); } } while (0)
#define APP_STEP(tt, K0, K1, V) do { \
            if ((tt) > 0 && (tt) - 1 < ntw) APP_Z((tt) - 1); \
            if ((tt) < ntw) APP_X(tt); \
            if (grpB) { APP_WRITE(K0, K1, V, (tt) + 1, (tt)); APP_LOAD(K0, K1, V, (tt) + 3, (tt) + 2); } \
            APP_BAR(); \
            if ((tt) < ntw) APP_Y(tt); \
            if (!grpB) { APP_WRITE(K0, K1, V, (tt) + 1, (tt)); APP_LOAD(K0, K1, V, (tt) + 3, (tt) + 2); } \
            APP_BAR(); } while (0)
        for (int t = 0; t < ntile; t += 2) {
            APP_STEP(t, kb0, kb1, vb);
            if (t + 1 < ntile) APP_STEP(t + 1, ka0, ka1, va);
        }
        if (ntile - 1 < ntw) APP_Z(ntile - 1);
        if (qrow >= 0) {
            const float inv = 1.0f / (lrun + __shfl_xor(lrun, 32));
            if (q < nvalid) { bf16_t* op = ATT + (size_t)(qrow + q) * 1024 + hg * 64 + 4 * hl;
#pragma unroll
                for (int ig = 0; ig < 4; ++ig) {
                    st_bf4(op + 8 * ig, (f32x4){o0[4 * ig] * inv, o0[4 * ig + 1] * inv, o0[4 * ig + 2] * inv, o0[4 * ig + 3] * inv});
                    st_bf4(op + 32 + 8 * ig, (f32x4){o1[4 * ig] * inv, o1[4 * ig + 1] * inv, o1[4 * ig + 2] * inv, o1[4 * ig + 3] * inv}); } }
        }
        if (!grpB) APP_BAR();
    }
#undef APP_BAR
#undef APP_LOAD
#undef APP_WRITE
#undef APP_Z
#undef APP_X
#undef APP_Y
#undef APP_STEP
}
DI void attn_phase(const Params& p, LAS unsigned char* lds, int hh) {
    const int lane = threadIdx.x & 63;
    float mq = fmaxf(fabsf(p.in[I_QN][lane]), lane < 32 ? fabsf(p.in[I_QN][64 + lane]) : 0.f), mk = fmaxf(fabsf(p.in[I_KN][lane]), lane < 32 ? fabsf(p.in[I_KN][64 + lane]) : 0.f);
#pragma unroll
    for (int o = 1; o < 64; o <<= 1) { mq = fmaxf(mq, __shfl_xor(mq, o)); mk = fmaxf(mk, __shfl_xor(mk, o)); }
    const float m0 = 96.0f * 0.10206207261596575f * 1.4426950408889634f * 1.02f * mq * mk;
    if (m0 < 40.0f) attn_pp(p, lds, hh, m0); else attn_body<false>(p, lds, hh, 0.f);
}
DI void kv_half(const Params& p, LAS unsigned char* lds, int hh) {
    unsigned char* ws = p.ws;
    int K128 = 128; asm volatile("" : "+s"(K128));
    EpiK ek{(bf16_t*)(ws + OFF_KH), (const bf16_t*)(ws + OFF_KPE), p.in[I_KN]};
    run_gemm(lds, (const bf16_t*)(ws + OFF_CKV), (const bf16_t*)(ws + OFF_WK) + (size_t)hh * 512 * 128, MK, 512, K128, ek, 40);
    EpiVt ev{(bf16_t*)(ws + OFF_VT)};
    run_gemm(lds, (const bf16_t*)(ws + OFF_WVT) + (size_t)hh * 512 * 128, (const bf16_t*)(ws + OFF_CKV), 512, MK, K128, ev, 80);
}

constexpr int NPHASE = 17;
#ifndef ONLY
#define ONLY -1
#endif
#ifndef REP_PH
#define REP_PH -1
#endif
#ifndef REP_CNT
#define REP_CNT 1
#endif
#define PHASE(n, ...) if ((ONLY < 0 || ONLY == (n)) && p.ph_lo <= (n) && (n) < p.ph_hi) { \
    for (int rep_ = 0; rep_ < ((n) == REP_PH ? REP_CNT : 1); ++rep_) { __VA_ARGS__ if ((n) == REP_PH && rep_ + 1 < REP_CNT) xcd_barrier(xb); } \
    if ((n) + 1 < p.ph_hi) { if ((n) == 0) cg::this_grid().sync(); else xcd_barrier(xb); } }
DI void ph_swiglu(const Params& p, LAS unsigned char* lds, size_t woff) {
    EpiSwiglu e{(bf16_t*)(p.ws + OFF_ACT)};
    run_gemm(lds, (const bf16_t*)(p.ws + OFF_H), (const bf16_t*)(p.ws + woff), M, 5632, 1024, e, 0);
}
DI void tail_final(const Params& p) {
    const int lane = threadIdx.x & 63; const float* P = (const float*)(p.ws + OFF_ATT);
    for (int r = M_MAIN + blockIdx.x * 8 + (threadIdx.x >> 6); r < M; r += gridDim.x * 8) { f32x4 t[4]; tail_sum(P, r, 11, lane, t); float* xd = xrow_dst(p, r);
#pragma unroll
        for (int j = 0; j < 4; ++j) { const f32x4 x = *(const f32x4*)(xd + 4 * (lane + 64 * j)); *(f32x4*)(xd + 4 * (lane + 64 * j)) = x + 0.5f * t[j]; } }
}
DI void ph_resid(const Params& p, LAS unsigned char* lds, size_t aoff, size_t woff, int K, int src0, float scale) {
    EpiResid e{p.in[I_XP], p.in[I_META], p.in[I_XS], p.out, (float*)(p.ws + OFF_XM), src0, scale};
    run_gemm(lds, (const bf16_t*)(p.ws + aoff), (const bf16_t*)(p.ws + woff), M_MAIN, 1024, K, e, 0);
    EpiPartial ep{(float*)(p.ws + OFF_ATT)};
    int KS = 256; asm volatile("" : "+s"(KS));
    const int vb = (int)*(volatile LAS unsigned*)(lds + 131072 + 8);
    pg8::Gemm g{(const bf16_t*)(p.ws + aoff), (const bf16_t*)(p.ws + woff), M, 1024, KS, K};
    pg8::TailOrder T; T.pm0 = M_MAIN / 256; T.npm = NTAILP; T.nN = 4; T.S = K / 256; T.G = (int)gridDim.x; T.c = (vb + 100) % (int)gridDim.x;
    pg8::gemm_phase<EpiPartial, pg8::TailOrder>(lds, g, T, ep);
}
__global__ __launch_bounds__(512, 2) void mega(Params p) {
    extern __shared__ __attribute__((aligned(16))) unsigned char shm[];
    LAS unsigned char* lds = (LAS unsigned char*)shm;
    unsigned char* ws = p.ws;
    XcdBarrier xb; xb.bar = (unsigned*)(ws + OFF_BAR); xb.x = xb_xcc_id(); xb.st = (volatile LAS unsigned*)(lds + 131072);
    if (threadIdx.x == 0) { xb.st[0] = 0u; xb.st[1] = 0u; const unsigned rank = xb_add(&xb.bar[XB_XCNT(xb.x)], 1u); xb.st[2] = blockIdx.x; xb.st[3] = rank; }
    __syncthreads();
    PHASE(0, phase_prep(p, lds);)
    if (threadIdx.x == 0) {
        bool even = (gridDim.x % 8u) == 0u;
        for (unsigned j = 0; j < 16; ++j) { const unsigned c = xb_ld(&xb.bar[XB_XCNT(j)]); even = even && (c == (j < 8u ? gridDim.x / 8u : 0u)); }
        if (even && p.ph_lo == 0 && p.ph_hi > 1) xb.st[2] = xb.st[3] * 8u + xb.x;
    }
    __syncthreads();
    PHASE(1, ph_swiglu(p, lds, OFF_W1GU);)
    PHASE(2, ph_resid(p, lds, OFF_ACT, OFF_W1D, 2816, 1, 0.5f);)
    PHASE(3, norm_rows(p, 0, p.in[I_MIXN], (bf16_t*)(ws + OFF_H), 11, 0.5f, 1);)
    PHASE(4, { EpiInProj e{(bf16_t*)(ws + OFF_BG), (bf16_t*)(ws + OFF_CIN), (bf16_t*)(ws + OFF_GC), (bf16_t*)(ws + OFF_GM), (bf16_t*)(ws + OFF_ZQ), (float*)(ws + OFF_ZL)};
            run_gemm(lds, (const bf16_t*)(ws + OFF_H), (const bf16_t*)(ws + OFF_WIN), M, NIN, 1024, e, 0); })
    PHASE(5, phase_lat_conv(p);)
    PHASE(6, { EpiGate e{(bf16_t*)(ws + OFF_H), (const bf16_t*)(ws + OFF_GC), nullptr};
            run_gemm(lds, (const bf16_t*)(ws + OFF_BG), (const bf16_t*)(ws + OFF_WCO), M, 1024, 1024, e, 0); })
    PHASE(7, {  EpiQup e{(bf16_t*)(ws + OFF_QR), (const float*)(ws + OFF_RQ)};
                run_gemm(lds, (const bf16_t*)(ws + OFF_ZQ), (const bf16_t*)(ws + OFF_WUQ), M, 1536, 384, e, 0);
                const int gt = blockIdx.x * 512 + threadIdx.x; const int NT = gridDim.x * 512;
                for (int i = gt; i < 8 * 768; i += NT) *(u32x4*)(ws + OFF_KH + (((size_t)(i / 768) * MKP + MK) * 96) * 2 + (size_t)(i % 768) * 16) = (u32x4){0, 0, 0, 0};
                for (int i = gt; i < 8 * 32 * 64 * 16; i += NT) { const int c4 = i & 15, d = (i >> 4) & 63, sq = (i >> 10) & 31, hh_ = i >> 15;
                    const int tile = sq < 16 ? sq * 65 + 64 : 16 * 65 + (sq - 16) * 33 + 32, j0 = sq < 16 ? 16 : 32;
                    if (c4 * 4 >= j0) *(u32x2*)(ws + OFF_VT + (((((size_t)hh_ * NVT + tile) * 64 + d) << 6) + c4 * 4) * 2) = (u32x2){0, 0}; }
                kv_half(p, lds, 0); })
    PHASE(8, attn_phase(p, lds, 0);)
    PHASE(9, kv_half(p, lds, 1);)
    PHASE(10, attn_phase(p, lds, 1);)
    PHASE(11, { EpiGate e{(bf16_t*)(ws + OFF_MG), (const bf16_t*)(ws + OFF_GM), (const bf16_t*)(ws + OFF_H)};
            run_gemm(lds, (const bf16_t*)(ws + OFF_ATT), (const bf16_t*)(ws + OFF_WMO), M, 1024, 1024, e, 0); })
    PHASE(12, ph_resid(p, lds, OFF_MG, OFF_WOUT, 1024, 0, 1.0f);)
    PHASE(13, norm_rows(p, 0, p.in[I_F2N], (bf16_t*)(ws + OFF_H), 4, 1.0f, 0);)
    PHASE(14, ph_swiglu(p, lds, OFF_W2GU);)
    PHASE(15, ph_resid(p, lds, OFF_ACT, OFF_W2D, 2816, 0, 0.5f);)
    PHASE(16, tail_final(p);)
}

constexpr int LDS_BYTES = 131072 + 16;
extern "C" void kernel_launch(void* const* d_in, const int* in_sizes, int n_in, void* d_out, int out_size, void* d_ws, size_t ws_size, hipStream_t stream) {
    static int grid = 0;
    if (grid == 0) {
        if (n_in != 26 || ws_size < WS_END) { fprintf(stderr, "kernel_launch: need 26 inputs and %zu bytes of workspace (got %d, %zu)\n", (size_t)WS_END, n_in, ws_size); grid = -1; return; }
        int dev = 0, cus = 0, per_cu = 0;
        if (hipGetDevice(&dev) != hipSuccess || hipDeviceGetAttribute(&cus, hipDeviceAttributeMultiprocessorCount, dev) != hipSuccess) { grid = -1; return; }
        if (hipFuncSetAttribute((const void*)mega, hipFuncAttributeMaxDynamicSharedMemorySize, LDS_BYTES) != hipSuccess) { fprintf(stderr, "kernel_launch: hipFuncSetAttribute failed\n"); grid = -1; return; }
        if (hipOccupancyMaxActiveBlocksPerMultiprocessor(&per_cu, (const void*)mega, 512, LDS_BYTES) != hipSuccess || per_cu < 1) { fprintf(stderr, "kernel_launch: occupancy query says %d\n", per_cu); per_cu = 1; }
        (void)hipGetLastError();
        if (cus != 256) { fprintf(stderr, "kernel_launch: built for a 256-CU device (got %d)\n", cus); grid = -1; return; }
        grid = 256;
    }
    if (grid < 0) return;
    if (hipMemsetAsync((char*)d_ws + OFF_BAR, 0, XCD_BAR_WORDS * 4, stream) != hipSuccess) { fprintf(stderr, "kernel_launch: memset failed\n"); return; }
    Params p{};
    for (int i = 0; i < 26; ++i) p.in[i] = (const float*)d_in[i];
    p.out = (float*)d_out; p.ws = (unsigned char*)d_ws;
#if N_LAUNCH_MODE == 1
    p.ph_lo = 0; p.ph_hi = NPHASE;
    void* args[] = {&p};
    hipError_t e = hipLaunchCooperativeKernel((const void*)mega, dim3(grid), dim3(512), args, LDS_BYTES, stream);
    if (e != hipSuccess) fprintf(stderr, "cooperative launch failed: %s (grid %d)\n", hipGetErrorString(e), grid);
#else
    for (int ph = 0; ph < NPHASE; ++ph) { p.ph_lo = ph; p.ph_hi = ph + 1; hipLaunchKernelGGL(mega, dim3(grid), dim3(512), LDS_BYTES, stream, p); }
#endif
}
```

```cpp
#include <hip/hip_runtime.h>
#include <hip/hip_cooperative_groups.h>
#include <cstdio>
namespace cg = cooperative_groups;

#ifndef N_LAUNCH_MODE
#define N_LAUNCH_MODE 1
#endif

#define LAS __attribute__((address_space(3)))
#define DI __device__ __forceinline__
typedef unsigned short bf16_t;
typedef short bf16x8 __attribute__((ext_vector_type(8)));
typedef float f32x4 __attribute__((ext_vector_type(4)));
typedef float f32x2 __attribute__((ext_vector_type(2)));
typedef float f32x16 __attribute__((ext_vector_type(16)));
typedef unsigned u32x4 __attribute__((ext_vector_type(4)));
typedef unsigned u32x2 __attribute__((ext_vector_type(2)));
typedef __bf16 bf16v2 __attribute__((ext_vector_type(2)));

constexpr int D = 1024, FF = 2816, NB = 16, LP = 4112, DS = 32, PAST = 2048;
constexpr int MP = NB * LP;
constexpr int MS = NB * DS;
constexpr int M = MP + MS;
constexpr int LSK = PAST + DS;
constexpr int MK = MP + NB * LSK;
constexpr int MKP = MK + 64;
constexpr int NIN = 5888;
constexpr float EPS = 1e-6f;

constexpr size_t OFF_W1GU = 0;
constexpr size_t OFF_W1D = OFF_W1GU + (size_t)5632 * 1024 * 2;
constexpr size_t OFF_WIN = OFF_W1D + (size_t)1024 * 2816 * 2;
constexpr size_t OFF_WUQ = OFF_WIN + (size_t)NIN * 1024 * 2;
constexpr size_t OFF_WK = OFF_WUQ + (size_t)1536 * 384 * 2;
constexpr size_t OFF_WVT = OFF_WK + (size_t)1024 * 256 * 2;
constexpr size_t OFF_WCO = OFF_WVT + (size_t)1024 * 256 * 2;
constexpr size_t OFF_WMO = OFF_WCO + (size_t)1024 * 1024 * 2;
constexpr size_t OFF_WOUT = OFF_WMO + (size_t)1024 * 1024 * 2;
constexpr size_t OFF_W2GU = OFF_WOUT + (size_t)1024 * 1024 * 2;
constexpr size_t OFF_W2D = OFF_W2GU + (size_t)5632 * 1024 * 2;
constexpr size_t OFF_ROT = OFF_W2D + (size_t)1024 * 2816 * 2;
constexpr size_t OFF_RQ = OFF_ROT + (size_t)LP * 16 * 8;
constexpr size_t OFF_XM = OFF_RQ + (size_t)M * 4;
constexpr size_t OFF_BAR = OFF_XM + (size_t)256 * 1024 * 4;
constexpr size_t RB = (size_t)60 << 20;
static_assert(OFF_BAR + 16384 <= RB, "weights region overflow");
static_assert(OFF_XM % 16 == 0 && OFF_RQ % 16 == 0 && OFF_ROT % 16 == 0, "align");
constexpr size_t EU = (size_t)M * 256;
constexpr size_t OFF_H = RB + 0 * EU;
constexpr size_t OFF_GM = RB + 8 * EU;
constexpr size_t OFF_ZQ = RB + 16 * EU;
constexpr size_t OFF_CKV = RB + 19 * EU;
constexpr size_t OFF_KPE = RB + 22 * EU;
constexpr size_t OFF_BG = RB + 23 * EU;
constexpr size_t OFF_CIN = RB + 31 * EU;
constexpr size_t OFF_GC = RB + 39 * EU;
constexpr size_t OFF_ZL = RB + 47 * EU;
constexpr size_t OFF_QR = RB + 23 * EU;
constexpr size_t OFF_KH = RB + 35 * EU;
constexpr size_t OFF_VT = RB + 44 * EU;
constexpr size_t OFF_ATT = RB + 51 * EU;
constexpr size_t OFF_MG = RB + 35 * EU;
constexpr size_t OFF_ACT = RB + 8 * EU;
constexpr size_t WS_END = RB + 59 * EU;
static_assert((size_t)MKP * 256 * 2 <= 3 * EU && (size_t)MKP * 32 * 2 <= EU && (size_t)M * 160 * 4 <= 3 * EU, "region sizes");
constexpr int NVT = 16 * 65 + 16 * 33;
static_assert((size_t)MKP * 768 * 2 <= 9 * EU && (size_t)8 * NVT * 4096 * 2 <= 7 * EU, "kv region sizes");

constexpr size_t OUT_YP = 0;
constexpr size_t OUT_YS = OUT_YP + (size_t)NB * 4096 * 1024;
constexpr size_t OUT_NCP = OUT_YS + (size_t)MS * 1024;
constexpr size_t OUT_KVP = OUT_NCP + (size_t)NB * 2 * 1024;
constexpr size_t OUT_KRP = OUT_KVP + (size_t)MP * 128;
constexpr size_t OUT_NCS = OUT_KRP + (size_t)MP * 32;
constexpr size_t OUT_KVS = OUT_NCS + (size_t)NB * 2 * 1024;
constexpr size_t OUT_KRS = OUT_KVS + (size_t)MS * 128;

struct Params {
    const float* in[26];
    float* out;
    unsigned char* ws;
    int ph_lo, ph_hi;
};
enum { I_XP = 0, I_XS, I_CCONV, I_CKV, I_CKR, I_META, I_F1N, I_F1G, I_F1U, I_F1D, I_MIXN, I_WIN, I_CONVW, I_WCO, I_QAN, I_WUQ, I_KVAN, I_WUKV, I_QN, I_KN, I_WMO, I_WOUT, I_F2N, I_F2G, I_F2U, I_F2D };

DI unsigned pk2(float a, float b) { bf16v2 v = __builtin_convertvector((f32x2){a, b}, bf16v2); return __builtin_bit_cast(unsigned, v); }
DI float bflo(unsigned u) { return __uint_as_float(u << 16); }
DI float bfhi(unsigned u) { return __uint_as_float(u & 0xffff0000u); }
DI float wave_sum(float v) {
#pragma unroll
    for (int o = 1; o < 64; o <<= 1) v += __shfl_xor(v, o);
    return v;
}
DI float* xrow_dst(const Params& p, int r) {
    if (r < MP) { const int b = r / LP, i = r - b * LP;
        if (i >= 16) return p.out + OUT_YP + ((size_t)b * 4096 + (i - 16)) * 1024;
        return (float*)(p.ws + OFF_XM) + (size_t)(b * 16 + i) * 1024; }
    return p.out + OUT_YS + (size_t)(r - MP) * 1024;
}
DI const float* xrow_src0(const Params& p, int r) {
    if (r < MP) { const int b = r / LP, i = r - b * LP;
        if (i >= 16) return p.in[I_XP] + ((size_t)b * 4096 + (i - 16)) * 1024;
        return p.in[I_META] + (size_t)i * 1024; }
    return p.in[I_XS] + (size_t)(r - MP) * 1024;
}


#define XB_TMO      128
#define XB_XCNT(j)  (256  + 64 * (j))
#define XB_XSUB(j)  (1280 + 64 * (j))
#define XB_XGEN(j)  (2304 + 64 * (j))
#define XB_TOP      3328
#define XB_TOPGEN   3392
#define XCD_BAR_WORDS 3456
#define XB_SPIN_CAP (1u << 22)
DI unsigned xb_ld(unsigned* p) { return __hip_atomic_load(p, __ATOMIC_RELAXED, __HIP_MEMORY_SCOPE_AGENT); }
DI unsigned xb_add(unsigned* p, unsigned v) { return __hip_atomic_fetch_add(p, v, __ATOMIC_RELAXED, __HIP_MEMORY_SCOPE_AGENT); }
DI unsigned xb_xcc_id() { return (unsigned)__builtin_amdgcn_s_getreg((3 << 11) | 20) & 0xFu; }
#define XB_SPIN(cond, bar) do { unsigned _sp = 0; while (cond) { __builtin_amdgcn_s_sleep(1); \
    if ((++_sp & 255u) == 0u) { if (xb_ld(&(bar)[XB_TMO])) break; if (_sp > XB_SPIN_CAP) { atomicAdd(&(bar)[XB_TMO], 1u); break; } } } } while (0)
struct XcdBarrier { unsigned* bar; unsigned x; volatile LAS unsigned* st; };
DI void xcd_barrier_complete(unsigned* bar, unsigned x, unsigned& nloc, unsigned& nx) {
    const unsigned G = gridDim.x;
    unsigned sum, cnt, mine, sp = 0u;
    for (;;) {
        sum = 0u; cnt = 0u; mine = 0u;
#pragma unroll
        for (unsigned j = 0; j < 16; ++j) { const unsigned c = xb_ld(&bar[XB_XCNT(j)]); sum += c; cnt += (c > 0u) ? 1u : 0u; mine = (j == x) ? c : mine; }
        if (sum == G) break;
        __builtin_amdgcn_s_sleep(1);
        if ((++sp & 255u) == 0u) { if (xb_ld(&bar[XB_TMO])) break; if (sp > XB_SPIN_CAP) { atomicAdd(&bar[XB_TMO], 1u); break; } }
    }
    nloc = mine > 0u ? mine : 1u; nx = cnt > 0u ? cnt : 1u;
}
DI void xcd_barrier(const XcdBarrier& b) {
    asm volatile("s_waitcnt vmcnt(0)" ::: "memory");
    __syncthreads();
    if (threadIdx.x == 0) {
        unsigned* bar = b.bar;
        __builtin_amdgcn_s_waitcnt(0);
        unsigned nloc = b.st[0], nx = b.st[1];
        if (nloc == 0u) { xcd_barrier_complete(bar, b.x, nloc, nx); b.st[0] = nloc; b.st[1] = nx; }
        const unsigned old = xb_add(&bar[XB_XSUB(b.x)], 1u);
        const unsigned gen = old / nloc;
        if (old + 1u == (gen + 1u) * nloc) {
            __builtin_amdgcn_fence(__ATOMIC_RELEASE, "agent");
            asm volatile("s_waitcnt vmcnt(0)" ::: "memory");
            const unsigned og = xb_add(&bar[XB_TOP], 1u);
            const unsigned tg = og / nx;
            if (og + 1u == (tg + 1u) * nx) xb_add(&bar[XB_TOPGEN], 1u);
            else XB_SPIN(xb_ld(&bar[XB_TOPGEN]) == tg, bar);
            __builtin_amdgcn_fence(__ATOMIC_ACQUIRE, "agent");
            xb_add(&bar[XB_XGEN(b.x)], 1u);
            asm volatile("s_waitcnt vmcnt(0)" ::: "memory");
        } else {
            XB_SPIN(xb_ld(&bar[XB_XGEN(b.x)]) == gen, bar);
            __builtin_amdgcn_fence(__ATOMIC_ACQUIRE, "agent");
            asm volatile("s_waitcnt vmcnt(0)" ::: "memory");
        }
    }
    __syncthreads();
}

namespace pg8 {
constexpr int BM = 256, BK = 64, HALF = 128, HTB = HALF * BK * 2, STAGE_BYTES = 8 * HTB, NXCD = 8, WGM = 8;
DI int lds_byte(int r, int c) { const int st = (r >> 4) * 2 + (c >> 5), rr = r & 15, cc = c & 31, ob = rr * 64 + cc * 2; return st * 1024 + (ob ^ (((ob >> 9) & 1) << 5)); }
DI void stage_rc(int b, int& R, int& C) { const int st = b / 1024, sb = b % 1024, swz = sb ^ (((sb >> 9) & 1) << 5); R = (st >> 1) * 16 + swz / 64; C = (st & 1) * 32 + (swz % 64) / 2; }
struct Unit { int pm, pn, ks; };
struct Gemm { const bf16_t* A; const bf16_t* Bt; int M, N, K, ld; };
struct StaticOrder {
    int nM, nN, nwg, G, c;
    DI void init(int M_, int N_, int G_, int c_) { nM = M_ / BM; nN = N_ / BM; nwg = nM * nN; G = G_; c = c_; }
    DI bool next(int i, Unit& u) const {
        const long L = (long)i * G + c; if (L >= nwg) return false;
        int wgid = (int)L; { const int q = nwg / NXCD, r = nwg % NXCD, xcd = wgid % NXCD, off = wgid / NXCD; wgid = (xcd < r ? xcd * (q + 1) : r * (q + 1) + (xcd - r) * q) + off; }
        const int nig = WGM * nN, gid = wgid / nig, fm = gid * WGM, gsz = (nM - fm) < WGM ? (nM - fm) : WGM;
        u.pm = fm + ((wgid % nig) % gsz); u.pn = (wgid % nig) / gsz; u.ks = 0; return true;
    }
};
struct TailOrder {
    int pm0, npm, nN, S, G, c;
    DI bool next(int i, Unit& u) const {
        const long L = (long)i * G + c; if (L >= (long)npm * nN * S) return false;
        const int l = (int)L; u.ks = l % S; const int t = l / S; u.pn = t % nN; u.pm = pm0 + t / nN; return true;
    }
};
template <class Epi, class Sched>
DI void gemm_phase(LAS unsigned char* lds, const Gemm g, const Sched& S, const Epi& E) {
    const int tid = threadIdx.x, wid = __builtin_amdgcn_readfirstlane(tid >> 6), lane = tid & 63, wr = wid >> 2, wc = wid & 3, fr = lane & 15, fq = lane >> 4;
    const int K = g.K, nt = K / BK, ld = g.ld;
    unsigned voffA[2], voffB[2];
#pragma unroll
    for (int i = 0; i < 2; ++i) { int R, C; stage_rc(tid * 16 + i * 8192, R, C); voffA[i] = (unsigned)(R * ld + C) * 2u;
        const int r32 = R & 31, Rb = Epi::PERMB ? (R & ~31) + 8 * ((r32 >> 2) & 3) + 4 * (r32 >> 4) + (r32 & 3) : R; voffB[i] = (unsigned)(Rb * ld + C) * 2u; }
    const size_t kstep = (size_t)(BK * 2);
    const size_t hstep = (size_t)HALF * ld * 2;
    const size_t tstep = 2 * hstep;
    const unsigned ldsw = (unsigned)wid * 1024u;
    const int aoff = lds_byte(wr * 64 + fr, fq * 8), boff = lds_byte(wc * 32 + fr, fq * 8);
#define PG8_SA(b, h) (((b) * 2 + (h)) * HTB)
#define PG8_SB(b, h) ((4 + (b) * 2 + (h)) * HTB)
#define PG8_STAGE(bufoff, gbase, voff) do { _Pragma("unroll") for (int _i = 0; _i < 2; ++_i) \
        __builtin_amdgcn_global_load_lds((const unsigned*)((const char*)(gbase) + (voff)[_i]), (LAS unsigned*)(lds + (bufoff) + ldsw + _i * 8192), 16, 0, 0); } while (0)
#define PG8_LDA(dst, b, h) do { _Pragma("unroll") for (int m = 0; m < 4; ++m) _Pragma("unroll") for (int k = 0; k < 2; ++k) dst[m][k] = *(const LAS bf16x8*)(lds + PG8_SA(b, h) + aoff + m * 2048 + k * 1024); } while (0)
#define PG8_LDB(dst, b, h) do { _Pragma("unroll") for (int n = 0; n < 2; ++n) _Pragma("unroll") for (int k = 0; k < 2; ++k) dst[n][k] = *(const LAS bf16x8*)(lds + PG8_SB(b, h) + boff + n * 2048 + k * 1024); } while (0)
#define PG8_MMA(ai, bj, At, Bt) do { __builtin_amdgcn_s_setprio(1); _Pragma("unroll") for (int m = 0; m < 4; ++m) _Pragma("unroll") for (int n = 0; n < 2; ++n) _Pragma("unroll") for (int k = 0; k < 2; ++k) \
        acc[ai][bj][m][n] = __builtin_amdgcn_mfma_f32_16x16x32_bf16(Bt[n][k], At[m][k], acc[ai][bj][m][n], 0, 0, 0); __builtin_amdgcn_s_setprio(0); } while (0)
#define PG8_WAIT_V(n) asm volatile("s_waitcnt vmcnt(" #n ")" ::: "memory")
#define PG8_WAIT_L(n) asm volatile("s_waitcnt lgkmcnt(" #n ")" ::: "memory")
#define PG8_BAR __builtin_amdgcn_s_barrier()
#define PG8_SCHED __builtin_amdgcn_sched_barrier(0)
    Unit cur, nxt; int ui = 0;
    if (!S.next(0, cur)) return;
    f32x4 acc[2][2][4][2];
#pragma unroll
    for (int a = 0; a < 2; ++a)
#pragma unroll
        for (int b = 0; b < 2; ++b)
#pragma unroll
            for (int m = 0; m < 4; ++m)
#pragma unroll
                for (int n = 0; n < 2; ++n) acc[a][b][m][n] = (f32x4){0.f, 0.f, 0.f, 0.f};
    bf16x8 At[4][2], B0[2][2], B1[2][2];
    const char* cA = (const char*)g.A + (size_t)cur.pm * tstep + (size_t)cur.ks * K * 2; const char* cB = (const char*)g.Bt + (size_t)cur.pn * tstep + (size_t)cur.ks * K * 2;
    PG8_STAGE(PG8_SB(0, 0), cB, voffB); PG8_STAGE(PG8_SA(0, 0), cA, voffA); PG8_STAGE(PG8_SB(0, 1), cB + hstep, voffB); PG8_STAGE(PG8_SA(0, 1), cA + hstep, voffA);
    if (wr == 1) PG8_BAR;
    PG8_WAIT_V(4); PG8_BAR;
    PG8_STAGE(PG8_SB(1, 0), cB + kstep, voffB); PG8_STAGE(PG8_SA(1, 0), cA + kstep, voffA); PG8_STAGE(PG8_SB(1, 1), cB + hstep + kstep, voffB);
    PG8_WAIT_V(6); PG8_BAR;
    for (;;) {
        const bool has_next = S.next(ui + 1, nxt);
        const char* nA = has_next ? (const char*)g.A + (size_t)nxt.pm * tstep + (size_t)nxt.ks * K * 2 : cA; const char* nB = has_next ? (const char*)g.Bt + (size_t)nxt.pn * tstep + (size_t)nxt.ks * K * 2 : cB;
#pragma unroll 1
        for (int t = 0; t < nt; t += 2) {
            const bool last = (t == nt - 2);
            const char* a1 = cA + (size_t)(t + 1) * kstep;
            const char* a2 = last ? nA : cA + (size_t)(t + 2) * kstep; const char* b2 = last ? nB : cB + (size_t)(t + 2) * kstep;
            const char* a3 = a2 + kstep; const char* b3 = b2 + kstep;
            PG8_LDB(B0, 0, 0); PG8_SCHED; PG8_LDA(At, 0, 0); PG8_STAGE(PG8_SA(1, 1), a1 + hstep, voffA);
            PG8_WAIT_L(8); PG8_BAR; PG8_WAIT_L(0); PG8_MMA(0, 0, At, B0); PG8_BAR; PG8_SCHED;
            PG8_LDB(B1, 0, 1); PG8_STAGE(PG8_SB(0, 0), b2, voffB);
            PG8_BAR; PG8_WAIT_L(0); PG8_MMA(0, 1, At, B1); PG8_BAR;
            PG8_LDA(At, 0, 1); PG8_STAGE(PG8_SA(0, 0), a2, voffA);
            PG8_BAR; PG8_WAIT_L(0); PG8_MMA(1, 0, At, B0); PG8_BAR; PG8_SCHED;
            PG8_STAGE(PG8_SB(0, 1), b2 + hstep, voffB);
            PG8_WAIT_V(6); PG8_BAR; PG8_MMA(1, 1, At, B1); PG8_BAR;
            PG8_LDB(B0, 1, 0); PG8_SCHED; PG8_LDA(At, 1, 0); PG8_STAGE(PG8_SA(0, 1), a2 + hstep, voffA);
            PG8_WAIT_L(8); PG8_BAR; PG8_WAIT_L(0); PG8_MMA(0, 0, At, B0); PG8_BAR; PG8_SCHED;
            PG8_LDB(B1, 1, 1); PG8_STAGE(PG8_SB(1, 0), b3, voffB);
            PG8_BAR; PG8_WAIT_L(0); PG8_MMA(0, 1, At, B1); PG8_BAR;
            PG8_LDA(At, 1, 1); PG8_STAGE(PG8_SA(1, 0), a3, voffA);
            PG8_BAR; PG8_WAIT_L(0); PG8_MMA(1, 0, At, B0); PG8_BAR; PG8_SCHED;
            PG8_STAGE(PG8_SB(1, 1), b3 + hstep, voffB);
            PG8_WAIT_V(6); PG8_BAR; PG8_MMA(1, 1, At, B1); PG8_BAR;
        }
        E(acc, cur, wr, wc, fr, fq);
        if (!has_next) break;
#pragma unroll
        for (int a = 0; a < 2; ++a)
#pragma unroll
            for (int b = 0; b < 2; ++b)
#pragma unroll
                for (int m = 0; m < 4; ++m)
#pragma unroll
                    for (int n = 0; n < 2; ++n) acc[a][b][m][n] = (f32x4){0.f, 0.f, 0.f, 0.f};
        cur = nxt; cA = nA; cB = nB; ++ui;
    }
    PG8_WAIT_V(0);
    if (wr == 0) PG8_BAR;
    PG8_BAR;
#undef PG8_SA
#undef PG8_SB
#undef PG8_STAGE
#undef PG8_LDA
#undef PG8_LDB
#undef PG8_MMA
#undef PG8_WAIT_V
#undef PG8_WAIT_L
#undef PG8_BAR
#undef PG8_SCHED
}
}
using pg8::Unit;
typedef f32x4 Acc[2][2][4][2];

DI int fresh_lane() { int l; asm volatile("v_mbcnt_lo_u32_b32 %0, -1, 0\n\tv_mbcnt_hi_u32_b32 %0, -1, %0" : "=v"(l)); return l; }
#define EPI_ROWS(ai, m) for (int ai = 0; ai < 2; ++ai) _Pragma("unroll") for (int m = 0; m < 4; ++m)
DI void st_bf4(bf16_t* p, f32x4 v) { u32x2 w; w.x = pk2(v[0], v[1]); w.y = pk2(v[2], v[3]); *(u32x2*)p = w; }
DI float sigm2(float x) { return __builtin_amdgcn_rcpf(1.0f + __builtin_amdgcn_exp2f(-x)); }

DI void st_bf8(bf16_t* p, f32x4 a, f32x4 b) { u32x4 w; w.x = pk2(a[0], a[1]); w.y = pk2(a[2], a[3]); w.z = pk2(b[0], b[1]); w.w = pk2(b[2], b[3]); *(u32x4*)p = w; }
struct EpiSwiglu {
    static constexpr bool PERMB = false;
    bf16_t* O;
    DI void operator()(const Acc& acc, const Unit& u, int wr, int wc, int fr_, int fq_) const {
        const int lane_ = fresh_lane(), fr = lane_ & 15, fq = lane_ >> 4;
        const int row0 = u.pm * 256 + wr * 64 + fr, col0 = u.pn * 128 + wc * 32 + 8 * fq;
#pragma unroll
        EPI_ROWS(ai, m) { bf16_t* rp = O + (size_t)(row0 + ai * 128 + m * 16) * FF + col0; f32x4 v[2];
#pragma unroll
            for (int n = 0; n < 2; ++n) { const f32x4 g = acc[ai][0][m][n], up = acc[ai][1][m][n];
#pragma unroll
                for (int j = 0; j < 4; ++j) v[n][j] = g[j] * up[j] * sigm2(g[j]); }
            st_bf8(rp, v[0], v[1]); }
    }
};
struct EpiResid {
    static constexpr bool PERMB = false;
    const float *xp, *meta, *xs; float* out; float* xm; int src0; float scale;
    DI float* drow(int r) const {
        if (r < MP) { const int b = r / LP, i = r - b * LP;
            if (i >= 16) return out + OUT_YP + ((size_t)b * 4096 + (i - 16)) * 1024;
            return xm + (size_t)(b * 16 + i) * 1024; }
        return out + OUT_YS + (size_t)(r - MP) * 1024; }
    DI const float* srow(int r) const {
        if (r < MP) { const int b = r / LP, i = r - b * LP;
            if (i >= 16) return xp + ((size_t)b * 4096 + (i - 16)) * 1024;
            return meta + (size_t)i * 1024; }
        return xs + (size_t)(r - MP) * 1024; }
    DI void operator()(const Acc& acc, const Unit& u, int wr, int wc, int fr_, int fq_) const {
        const int lane_ = fresh_lane(), fr = lane_ & 15, fq = lane_ >> 4;
        const int row0 = u.pm * 256 + wr * 64 + fr, col0 = u.pn * 256 + wc * 32 + 8 * fq;
        f32x4 xa[2][2][2], xb[2][2][2];
#define ER_LOAD(X, Q) do { _Pragma("unroll") for (int mm = 0; mm < 2; ++mm) { const int r_ = row0 + ((Q) >> 1) * 128 + (2 * ((Q) & 1) + mm) * 16; \
            const float* sp_ = (src0 ? srow(r_) : (const float*)drow(r_)) + col0; \
            _Pragma("unroll") for (int bj = 0; bj < 2; ++bj) _Pragma("unroll") for (int n = 0; n < 2; ++n) X[mm][bj][n] = *(const f32x4*)(sp_ + bj * 128 + n * 4); } } while (0)
#define ER_STORE(X, Q) do { _Pragma("unroll") for (int mm = 0; mm < 2; ++mm) { const int r_ = row0 + ((Q) >> 1) * 128 + (2 * ((Q) & 1) + mm) * 16; float* dp_ = drow(r_) + col0; \
            _Pragma("unroll") for (int bj = 0; bj < 2; ++bj) _Pragma("unroll") for (int n = 0; n < 2; ++n) \
                *(f32x4*)(dp_ + bj * 128 + n * 4) = X[mm][bj][n] + scale * acc[(Q) >> 1][bj][2 * ((Q) & 1) + mm][n]; } } while (0)
        ER_LOAD(xa, 0); ER_LOAD(xb, 1);
        ER_STORE(xa, 0); ER_LOAD(xa, 2);
        ER_STORE(xb, 1); ER_LOAD(xb, 3);
        ER_STORE(xa, 2); ER_STORE(xb, 3);
#undef ER_LOAD
#undef ER_STORE
    }
};
constexpr int M_MAIN = 65536, NTAILP = (M - M_MAIN) / 256;
struct EpiPartial {
    static constexpr bool PERMB = false;
    float* P;
    DI void operator()(const Acc& acc, const Unit& u, int wr, int wc, int fr_, int fq_) const {
        const int lane_ = fresh_lane(), fr = lane_ & 15, fq = lane_ >> 4;
        float* base = P + (size_t)((u.ks * NTAILP + (u.pm - M_MAIN / 256)) * 4 + u.pn) * 65536 + (size_t)(wr * 64 + fr) * 256 + wc * 32 + 8 * fq;
#pragma unroll
        EPI_ROWS(ai, m)
#pragma unroll
            for (int bj = 0; bj < 2; ++bj)
#pragma unroll
                for (int n = 0; n < 2; ++n) *(f32x4*)(base + (size_t)(ai * 128 + m * 16) * 256 + bj * 128 + n * 4) = acc[ai][bj][m][n];
    }
};
struct EpiInProj {
    static constexpr bool PERMB = false;
    bf16_t *BG, *CIN, *GC, *GM, *ZQ; float* ZL;
    DI void operator()(const Acc& acc, const Unit& u, int wr, int wc, int fr_, int fq_) const {
        const int lane_ = fresh_lane(), fr = lane_ & 15, fq = lane_ >> 4;
        const int row0 = u.pm * 256 + wr * 64 + fr, T = u.pn, cw = wc * 32 + 8 * fq;
        if (T >= 4 && T < 12) {
#pragma unroll
            EPI_ROWS(ai, m) st_bf8(CIN + (size_t)(row0 + ai * 128 + m * 16) * 1024 + (T - 4) * 128 + cw, acc[ai][0][m][0] * acc[ai][1][m][0], acc[ai][0][m][1] * acc[ai][1][m][1]);
        } else if (T < 4 || T == 20) {
            bf16_t* base = T < 4 ? BG + T * 256 : ZQ; const int ld = T < 4 ? 1024 : 384;
#pragma unroll
            EPI_ROWS(ai, m) { bf16_t* rp = base + (size_t)(row0 + ai * 128 + m * 16) * ld + cw;
#pragma unroll
                for (int bj = 0; bj < 2; ++bj) st_bf8(rp + bj * 128, acc[ai][bj][m][0], acc[ai][bj][m][1]); }
        } else if (T < 20) {
            bf16_t* base = T < 16 ? GC + (T - 12) * 256 : GM + (T - 16) * 256;
#pragma unroll
            EPI_ROWS(ai, m) { bf16_t* rp = base + (size_t)(row0 + ai * 128 + m * 16) * 1024 + cw;
#pragma unroll
                for (int bj = 0; bj < 2; ++bj) { f32x4 v[2];
#pragma unroll
                    for (int n = 0; n < 2; ++n)
#pragma unroll
                        for (int j = 0; j < 4; ++j) v[n][j] = sigm2(acc[ai][bj][m][n][j]);
                    st_bf8(rp + bj * 128, v[0], v[1]); } }
        } else if (T == 21) {
#pragma unroll
            EPI_ROWS(ai, m) { const size_t r = (size_t)(row0 + ai * 128 + m * 16);
                st_bf8(ZQ + r * 384 + 256 + cw, acc[ai][0][m][0], acc[ai][0][m][1]);
                *(f32x4*)(ZL + r * 160 + cw) = acc[ai][1][m][0]; *(f32x4*)(ZL + r * 160 + cw + 4) = acc[ai][1][m][1]; }
        } else {
            if (wc == 0) {
#pragma unroll
                EPI_ROWS(ai, m) { const size_t r = (size_t)(row0 + ai * 128 + m * 16);
                    *(f32x4*)(ZL + r * 160 + 128 + 8 * fq) = acc[ai][0][m][0]; *(f32x4*)(ZL + r * 160 + 128 + 8 * fq + 4) = acc[ai][0][m][1]; }
            }
        }
    }
};
struct EpiQup {
    static constexpr bool PERMB = false;
    bf16_t* O; const float* rq;
    DI void operator()(const Acc& acc, const Unit& u, int wr, int wc, int fr_, int fq_) const {
        const int lane_ = fresh_lane(), fr = lane_ & 15, fq = lane_ >> 4;
        const int row0 = u.pm * 256 + wr * 64 + fr, col0 = u.pn * 256 + wc * 32 + 8 * fq;
        float sc[2][4];
#pragma unroll
        for (int ai = 0; ai < 2; ++ai)
#pragma unroll
            for (int m = 0; m < 4; ++m) sc[ai][m] = rq[row0 + ai * 128 + m * 16];
#pragma unroll
        EPI_ROWS(ai, m) { const int r = row0 + ai * 128 + m * 16; const float s = sc[ai][m]; bf16_t* rp = O + (size_t)r * 1536 + col0;
#pragma unroll
            for (int bj = 0; bj < 2; ++bj) st_bf8(rp + bj * 128, acc[ai][bj][m][0] * s, acc[ai][bj][m][1] * s); }
    }
};
struct EpiGate {
    static constexpr bool PERMB = false;
    bf16_t* O; const bf16_t* gate; const bf16_t* add;
    DI void operator()(const Acc& acc, const Unit& u, int wr, int wc, int fr_, int fq_) const {
        const int lane_ = fresh_lane(), fr = lane_ & 15, fq = lane_ >> 4;
        const int row0 = u.pm * 256 + wr * 64 + fr, col0 = u.pn * 256 + wc * 32 + 8 * fq;
        u32x4 ga[2][2], aa[2][2], gb[2][2], ab[2][2];
#define EG_LOAD(G, A, Q) do { _Pragma("unroll") for (int mm = 0; mm < 2; ++mm) _Pragma("unroll") for (int bj = 0; bj < 2; ++bj) { \
            const size_t oo_ = (size_t)(row0 + ((Q) >> 1) * 128 + (2 * ((Q) & 1) + mm) * 16) * 1024 + col0 + bj * 128; \
            G[mm][bj] = *(const u32x4*)(gate + oo_); A[mm][bj] = add ? *(const u32x4*)(add + oo_) : (u32x4){0u, 0u, 0u, 0u}; } } while (0)
#define EG_STORE(G, A, Q) do { _Pragma("unroll") for (int mm = 0; mm < 2; ++mm) _Pragma("unroll") for (int bj = 0; bj < 2; ++bj) { \
            const size_t oo_ = (size_t)(row0 + ((Q) >> 1) * 128 + (2 * ((Q) & 1) + mm) * 16) * 1024 + col0 + bj * 128; \
            const u32x4 g = G[mm][bj], a2 = A[mm][bj]; const f32x4 a = acc[(Q) >> 1][bj][2 * ((Q) & 1) + mm][0], c = acc[(Q) >> 1][bj][2 * ((Q) & 1) + mm][1]; \
            st_bf8(O + oo_, (f32x4){bflo(a2.x) + bflo(g.x) * a[0], bfhi(a2.x) + bfhi(g.x) * a[1], bflo(a2.y) + bflo(g.y) * a[2], bfhi(a2.y) + bfhi(g.y) * a[3]}, \
                            (f32x4){bflo(a2.z) + bflo(g.z) * c[0], bfhi(a2.z) + bfhi(g.z) * c[1], bflo(a2.w) + bflo(g.w) * c[2], bfhi(a2.w) + bfhi(g.w) * c[3]}); } } while (0)
        EG_LOAD(ga, aa, 0); EG_LOAD(gb, ab, 1);
        EG_STORE(ga, aa, 0); EG_LOAD(ga, aa, 2);
        EG_STORE(gb, ab, 1); EG_LOAD(gb, ab, 3);
        EG_STORE(ga, aa, 2); EG_STORE(gb, ab, 3);
#undef EG_LOAD
#undef EG_STORE
    }
};
struct EpiK {
    static constexpr bool PERMB = false;
    bf16_t* K; const bf16_t* KPE; const float* kg_;
    DI void operator()(const Acc& acc, const Unit& u, int wr, int wc, int fr_, int fq_) const {
        const int lane_ = fresh_lane(), fr = lane_ & 15, fq = lane_ >> 4;
        const int row0 = u.pm * 256 + wr * 64 + fr, hl = 4 * u.pn + wc;
        const float* kg = kg_; asm volatile("" : "+s"(kg));
        f32x4 g[2][2]; f32x4 gr0 = *(const f32x4*)(kg + 64 + 8 * fq), gr1 = *(const f32x4*)(kg + 68 + 8 * fq);
#pragma unroll
        for (int bj = 0; bj < 2; ++bj)
#pragma unroll
            for (int n = 0; n < 2; ++n) g[bj][n] = *(const f32x4*)(kg + 32 * bj + 8 * fq + 4 * n);
        u32x4 kpv[2][4];
#pragma unroll
        for (int ai = 0; ai < 2; ++ai)
#pragma unroll
            for (int m = 0; m < 4; ++m) kpv[ai][m] = *(const u32x4*)(KPE + (size_t)(row0 + ai * 128 + m * 16) * 32 + 8 * fq);
#pragma unroll
        EPI_ROWS(ai, m) { const int r = row0 + ai * 128 + m * 16;
            const u32x4 kp = kpv[ai][m];
            f32x4 r0 = (f32x4){bflo(kp.x), bfhi(kp.x), bflo(kp.y), bfhi(kp.y)}, r1 = (f32x4){bflo(kp.z), bfhi(kp.z), bflo(kp.w), bfhi(kp.w)};
            float ss = 0.f;
#pragma unroll
            for (int j = 0; j < 4; ++j) ss += r0[j] * r0[j] + r1[j] * r1[j];
#pragma unroll
            for (int bj = 0; bj < 2; ++bj)
#pragma unroll
                for (int n = 0; n < 2; ++n) { const f32x4 a = acc[ai][bj][m][n]; ss += (a[0] * a[0] + a[1] * a[1]) + (a[2] * a[2] + a[3] * a[3]); }
            ss += __shfl_xor(ss, 16); ss += __shfl_xor(ss, 32);
            const float rs = __builtin_amdgcn_rsqf(ss * (1.0f / 96.0f) + EPS);
            bf16_t* kr = K + ((size_t)hl * MKP + r) * 96;
#pragma unroll
            for (int bj = 0; bj < 2; ++bj) st_bf8(kr + 32 * bj + 8 * fq, acc[ai][bj][m][0] * g[bj][0] * rs, acc[ai][bj][m][1] * g[bj][1] * rs);
            u32x4 w; r0 = r0 * gr0 * rs; r1 = r1 * gr1 * rs; w.x = pk2(r0[0], r0[1]); w.y = pk2(r0[2], r0[3]); w.z = pk2(r1[0], r1[1]); w.w = pk2(r1[2], r1[3]);
            *(u32x4*)(kr + 64 + 8 * fq) = w; }
    }
};
struct EpiVt {
    static constexpr bool PERMB = true;
    bf16_t* O;
    DI void operator()(const Acc& acc, const Unit& u, int wr, int wc, int fr_, int fq_) const {
        const int lane_ = fresh_lane(), fr = lane_ & 15, fq = lane_ >> 4;
        const int row0 = u.pm * 256 + wr * 64 + fr, col0 = u.pn * 256 + wc * 32 + 8 * fq;
#pragma unroll
        for (int bj = 0; bj < 2; ++bj) { const int r = col0 + bj * 128; int tile, j;
            if (r < MP) { const int b = r / LP, i = r - b * LP; tile = b * 65 + (i >> 6); j = i & 63; }
            else { const int r2 = r - MP, b = r2 / LSK, i = r2 - b * LSK; tile = 16 * 65 + b * 33 + (i >> 6); j = i & 63; }
#pragma unroll
            EPI_ROWS(ai, m) { const int row = row0 + ai * 128 + m * 16, hl = row >> 6, d = row & 63;
                st_bf8(O + ((((size_t)hl * NVT + tile) * 64 + d) << 6) + j, acc[ai][bj][m][0], acc[ai][bj][m][1]); } }
    }
};
template <class Epi> DI void run_gemm(LAS unsigned char* lds, const bf16_t* A, const bf16_t* Bt, int Mr, int N, int K, const Epi& E, int coff) {
    const int vb = (int)*(volatile LAS unsigned*)(lds + 131072 + 8);
    pg8::Gemm g{A, Bt, Mr, N, K, K}; pg8::StaticOrder S; S.init(Mr, N, (int)gridDim.x, (int)((vb + coff) % gridDim.x));
    pg8::gemm_phase<Epi, pg8::StaticOrder>(lds, g, S, E);
}

template <int KIND> DI float wval(const float* src, const float* qan, int np, int kp) {
    if (KIND == 0 || KIND == 2 || KIND == 3 || KIND == 4 || KIND == 6) { const int r = np & 31; np = (np & ~31) | (8 * ((r >> 2) & 3) + 4 * (r >> 4) + (r & 3)); }
    if (KIND == 6) return src[(size_t)kp * 1024 + np];
    if (KIND == 0) { const int T = np >> 8, e = np & 127; return src[(size_t)kp * FF + 128 * T + e] * (((np >> 7) & 1) ? 0.6931471805599453f : 1.4426950408889634f); }
    if (KIND == 1) return src[(size_t)kp * 1024 + np];
    if (KIND == 2) { const int T = np >> 8, r = np & 255; int col;
        if (T < 4) col = np;
        else if (T < 12) col = ((r >> 7) ? 2048 : 1024) + 128 * (T - 4) + (r & 127);
        else if (T < 16) col = 3616 + 256 * (T - 12) + r;
        else if (T < 20) col = 4640 + 256 * (T - 16) + r;
        else if (T == 20) col = 3072 + r;
        else if (T == 21) col = r < 128 ? 3072 + 256 + r : 3456 + (r - 128);
        else col = r < 32 ? 3584 + r : -1;
        return col < 0 ? 0.f : src[(size_t)kp * 5664 + col] * ((T >= 12 && T < 20) ? 1.4426950408889634f : 1.0f); }
    if (KIND == 3) return src[(size_t)kp * 1536 + np] * qan[kp];
    if (KIND == 4) { const int hh = np >> 9, pn = (np >> 8) & 1, bj = (np >> 7) & 1, wc = (np >> 5) & 3, e = np & 31; const int head = 8 * hh + 4 * pn + wc, dim = 32 * bj + e;
        return kp < 128 ? src[(size_t)kp * 2048 + head * 128 + dim] : 0.f; }
    return kp < 128 ? src[(size_t)kp * 2048 + (np >> 6) * 128 + 64 + (np & 63)] : 0.f;
}
template <int KIND> DI void wconv(const float* src, const float* src2, const float* qan, bf16_t* dst, int NP, int KP, LAS float* scr) {
    const int tid = threadIdx.x, nkt = KP >> 6, ntiles = (NP >> 6) * nkt;
    float cur[8], nxt[8];
#define WC_LOAD(dstv, tile_) do { const int ntl_ = (tile_) / nkt, kt_ = (tile_) - ntl_ * nkt, n0_ = ntl_ * 64, k0_ = kt_ * 64; \
        const float* sp_ = src; if (KIND == 0 && ((n0_ >> 7) & 1)) sp_ = src2; \
        _Pragma("unroll") for (int i = 0; i < 8; ++i) dstv[i] = wval<KIND>(sp_, qan, n0_ + (tid & 63), k0_ + (tid >> 6) + 8 * i); } while (0)
    int tile = blockIdx.x;
    if (tile < ntiles) WC_LOAD(cur, tile);
    for (; tile < ntiles; tile += gridDim.x) {
        const int ntl = tile / nkt, kt = tile - ntl * nkt, n0 = ntl * 64, k0 = kt * 64;
        const bool more = tile + (int)gridDim.x < ntiles;
        if (more) WC_LOAD(nxt, tile + (int)gridDim.x);
#pragma unroll
        for (int i = 0; i < 8; ++i) { const int kk = (tid >> 6) + 8 * i, nn = tid & 63; scr[kk * 65 + nn] = cur[i]; }
        __syncthreads();
#pragma unroll
        for (int i = 0; i < 8; ++i) { const int nn = (tid >> 6) + 8 * i, kk = tid & 63; dst[(size_t)(n0 + nn) * KP + k0 + kk] = (bf16_t)(pk2(scr[kk * 65 + nn], 0.f) & 0xffffu); }
        __syncthreads();
#pragma unroll
        for (int i = 0; i < 8; ++i) cur[i] = nxt[i];
    }
#undef WC_LOAD
}
DI void tail_sum(const float* P, int r, int S, int lane, f32x4 (&t)[4]) {
    const int pp = (r - M_MAIN) >> 8, rr = r & 255;
#pragma unroll
    for (int j = 0; j < 4; ++j) t[j] = (f32x4){0.f, 0.f, 0.f, 0.f};
    for (int s_ = 0; s_ < S; ++s_) {
#pragma unroll
        for (int j = 0; j < 4; ++j) t[j] += *(const f32x4*)(P + (size_t)((s_ * NTAILP + pp) * 4 + j) * 65536 + (size_t)rr * 256 + 4 * lane); }
}
DI void norm_rows(const Params& p, int from_src0, const float* gain, bf16_t* H, int tailS, float tscale, int tail_src0) {
    const int lane = threadIdx.x & 63, gw = blockIdx.x * 8 + (threadIdx.x >> 6), NGW = gridDim.x * 8;
    const float* P = (const float*)(p.ws + OFF_ATT);
    f32x4 gv[4];
#pragma unroll
    for (int j = 0; j < 4; ++j) gv[j] = *(const f32x4*)(gain + 4 * (lane + 64 * j));
    for (int r0 = gw; r0 < M; r0 += 4 * NGW) {
        f32x4 v[4][4]; float ss[4];
#pragma unroll
        for (int k = 0; k < 4; ++k) { const int r = r0 + k * NGW; const int rc = r < M ? r : r0; const bool tl = tailS > 0 && r >= M_MAIN && r < M; const float* x = (from_src0 || (tl && tail_src0)) ? xrow_src0(p, rc) : xrow_dst(p, rc);
#pragma unroll
            for (int j = 0; j < 4; ++j) v[k][j] = *(const f32x4*)(x + 4 * (lane + 64 * j));
            if (tl) { f32x4 t[4]; tail_sum(P, r, tailS, lane, t); float* xd = xrow_dst(p, r);
#pragma unroll
                for (int j = 0; j < 4; ++j) { v[k][j] += tscale * t[j]; *(f32x4*)(xd + 4 * (lane + 64 * j)) = v[k][j]; } } }
#pragma unroll
        for (int k = 0; k < 4; ++k) { float a = 0.f;
#pragma unroll
            for (int j = 0; j < 4; ++j) a += (v[k][j][0] * v[k][j][0] + v[k][j][1] * v[k][j][1]) + (v[k][j][2] * v[k][j][2] + v[k][j][3] * v[k][j][3]);
            ss[k] = a; }
#pragma unroll
        for (int o = 1; o < 64; o <<= 1) {
#pragma unroll
            for (int k = 0; k < 4; ++k) ss[k] += __shfl_xor(ss[k], o); }
#pragma unroll
        for (int k = 0; k < 4; ++k) { const int r = r0 + k * NGW; if (r < M) { const float rs = __builtin_amdgcn_rsqf(ss[k] * (1.0f / 1024.0f) + EPS);
#pragma unroll
            for (int j = 0; j < 4; ++j) st_bf4(H + (size_t)r * 1024 + 4 * (lane + 64 * j), v[k][j] * gv[j] * rs); } }
    }
}
DI void phase_prep(const Params& p, LAS unsigned char* lds) {
    unsigned char* ws = p.ws;
    LAS float* scr = (LAS float*)lds;
    wconv<0>(p.in[I_F1G], p.in[I_F1U], nullptr, (bf16_t*)(ws + OFF_W1GU), 5632, 1024, scr);
    wconv<6>(p.in[I_F1D], nullptr, nullptr, (bf16_t*)(ws + OFF_W1D), 1024, 2816, scr);
    wconv<2>(p.in[I_WIN], nullptr, nullptr, (bf16_t*)(ws + OFF_WIN), NIN, 1024, scr);
    wconv<3>(p.in[I_WUQ], nullptr, p.in[I_QAN], (bf16_t*)(ws + OFF_WUQ), 1536, 384, scr);
    wconv<4>(p.in[I_WUKV], nullptr, nullptr, (bf16_t*)(ws + OFF_WK), 1024, 128, scr);
    wconv<5>(p.in[I_WUKV], nullptr, nullptr, (bf16_t*)(ws + OFF_WVT), 1024, 128, scr);
    wconv<6>(p.in[I_WCO], nullptr, nullptr, (bf16_t*)(ws + OFF_WCO), 1024, 1024, scr);
    wconv<6>(p.in[I_WMO], nullptr, nullptr, (bf16_t*)(ws + OFF_WMO), 1024, 1024, scr);
    wconv<6>(p.in[I_WOUT], nullptr, nullptr, (bf16_t*)(ws + OFF_WOUT), 1024, 1024, scr);
    wconv<0>(p.in[I_F2G], p.in[I_F2U], nullptr, (bf16_t*)(ws + OFF_W2GU), 5632, 1024, scr);
    wconv<6>(p.in[I_F2D], nullptr, nullptr, (bf16_t*)(ws + OFF_W2D), 1024, 2816, scr);
    f32x2* rot = (f32x2*)(ws + OFF_ROT);
    for (int e = blockIdx.x * 512 + threadIdx.x; e < LP * 16; e += gridDim.x * 512) {
        const int pos = e >> 4, i = e & 15; double inv = 1.0;
        for (int k = 0; k < i; ++k) inv *= 0.56234132519034908;
        const double ang = (double)pos * inv; const double n = rint(ang * 0.15915494309189535);
        double r = fma(-n, 6.283185307179586, ang); r = fma(-n, 2.4492935982947064e-16, r);
        const double r2 = r * r; double tc = 1.0, sc = 1.0, tsn = r, ssn = r;
        for (int k = 1; k <= 14; ++k) { tc *= -r2 / (double)((2 * k - 1) * (2 * k)); sc += tc; tsn *= -r2 / (double)((2 * k) * (2 * k + 1)); ssn += tsn; }
        rot[e] = (f32x2){(float)sc, (float)ssn};
    }
    norm_rows(p, 1, p.in[I_F1N], (bf16_t*)(ws + OFF_H), 0, 0.f, 0);
}

DI void phase_lat_conv(const Params& p) {
    unsigned char* ws = p.ws;
    const int lane = threadIdx.x & 63, gw = blockIdx.x * 8 + (threadIdx.x >> 6), NGW = gridDim.x * 8;
    const float* ZL = (const float*)(ws + OFF_ZL); const bf16_t* ZQ = (const bf16_t*)(ws + OFF_ZQ);
    bf16_t* CKV = (bf16_t*)(ws + OFF_CKV); bf16_t* KPE = (bf16_t*)(ws + OFF_KPE); float* RQ = (float*)(ws + OFF_RQ);
    const f32x2* rot = (const f32x2*)(ws + OFF_ROT);
    const f32x4 gkv = *(const f32x4*)(p.in[I_KVAN] + 4 * (lane & 31));
    for (int r0 = gw; r0 < M; r0 += 4 * NGW) {
        f32x4 v[4]; float x1[4], x2[4]; f32x2 cs[4]; u32x4 zq[4]; int rr[4];
#pragma unroll
        for (int k = 0; k < 4; ++k) { const int r = r0 + k * NGW < M ? r0 + k * NGW : r0; rr[k] = r;
            const int pos = r < MP ? r % LP : 16 + PAST + ((r - MP) & 31);
            v[k] = (f32x4){0.f, 0.f, 0.f, 0.f}; x1[k] = 0.f; x2[k] = 0.f; cs[k] = (f32x2){0.f, 0.f}; zq[k] = (u32x4){0u, 0u, 0u, 0u};
            if (lane < 32) v[k] = *(const f32x4*)(ZL + (size_t)r * 160 + 4 * lane);
            if (lane < 16) { x1[k] = ZL[(size_t)r * 160 + 128 + lane]; x2[k] = ZL[(size_t)r * 160 + 144 + lane]; cs[k] = rot[pos * 16 + lane]; }
            if (lane < 48) zq[k] = *(const u32x4*)(ZQ + (size_t)r * 384 + 8 * lane); }
        float ss[4], sq[4];
#pragma unroll
        for (int k = 0; k < 4; ++k) { ss[k] = (v[k][0] * v[k][0] + v[k][1] * v[k][1]) + (v[k][2] * v[k][2] + v[k][3] * v[k][3]); const u32x4 z = zq[k];
            const float a0 = bflo(z.x), a1 = bfhi(z.x), a2 = bflo(z.y), a3 = bfhi(z.y), a4 = bflo(z.z), a5 = bfhi(z.z), a6 = bflo(z.w), a7 = bfhi(z.w);
            sq[k] = (a0 * a0 + a1 * a1) + (a2 * a2 + a3 * a3) + (a4 * a4 + a5 * a5) + (a6 * a6 + a7 * a7); }
#pragma unroll
        for (int o = 1; o < 64; o <<= 1) {
#pragma unroll
            for (int k = 0; k < 4; ++k) { ss[k] += __shfl_xor(ss[k], o); sq[k] += __shfl_xor(sq[k], o); } }
#pragma unroll
        for (int k = 0; k < 4; ++k) { const int r = rr[k]; if (r0 + k * NGW < M) {
            int keyrow; float *okv, *okr;
            if (r < MP) { keyrow = r; okv = p.out + OUT_KVP + (size_t)r * 128; okr = p.out + OUT_KRP + (size_t)r * 32; }
            else { const int rs_ = r - MP, b = rs_ >> 5, j = rs_ & 31; keyrow = MP + b * LSK + PAST + j; okv = p.out + OUT_KVS + (size_t)rs_ * 128; okr = p.out + OUT_KRS + (size_t)rs_ * 32; }
            const float rs = __builtin_amdgcn_rsqf(ss[k] * (1.0f / 128.0f) + EPS);
            const f32x4 vn = v[k] * gkv * rs;
            if (lane < 32) { *(f32x4*)(okv + 4 * lane) = vn; st_bf4(CKV + (size_t)keyrow * 128 + 4 * lane, vn); }
            if (lane < 16) { const float o1 = x1[k] * cs[k].x - x2[k] * cs[k].y, o2 = x2[k] * cs[k].x + x1[k] * cs[k].y; okr[lane] = o1; okr[16 + lane] = o2;
                KPE[(size_t)keyrow * 32 + lane] = (bf16_t)(pk2(o1, 0.f) & 0xffffu); KPE[(size_t)keyrow * 32 + 16 + lane] = (bf16_t)(pk2(o2, 0.f) & 0xffffu); }
            if (lane == 0) RQ[r] = __builtin_amdgcn_rsqf(sq[k] * (1.0f / 384.0f) + EPS); } }
    }
    for (int c0_ = gw; c0_ < NB * PAST; c0_ += 4 * NGW) {
        f32x4 a[4], c[4];
#pragma unroll
        for (int k = 0; k < 4; ++k) { const int cr = c0_ + k * NGW < NB * PAST ? c0_ + k * NGW : c0_; a[k] = (f32x4){0.f, 0.f, 0.f, 0.f}; c[k] = a[k];
            if (lane < 32) a[k] = *(const f32x4*)(p.in[I_CKV] + (size_t)cr * 128 + 4 * lane);
            if (lane < 8) c[k] = *(const f32x4*)(p.in[I_CKR] + (size_t)cr * 32 + 4 * lane); }
#pragma unroll
        for (int k = 0; k < 4; ++k) { const int cr = c0_ + k * NGW; if (cr < NB * PAST) { const int b = cr >> 11, j = cr & 2047, keyrow = MP + b * LSK + j;
            if (lane < 32) st_bf4(CKV + (size_t)keyrow * 128 + 4 * lane, a[k]);
            if (lane < 8) st_bf4(KPE + (size_t)keyrow * 32 + 4 * lane, c[k]); } }
    }
    {
        bf16_t* BG = (bf16_t*)(ws + OFF_BG); const bf16_t* CIN = (const bf16_t*)(ws + OFF_CIN);
        const int gt = blockIdx.x * 512 + threadIdx.x, NT = gridDim.x * 512, c8 = gt & 127, c0 = c8 * 8;
        float w0[8], w1[8], w2[8];
#pragma unroll
        for (int j = 0; j < 8; ++j) { w0[j] = p.in[I_CONVW][c0 + j]; w1[j] = p.in[I_CONVW][1024 + c0 + j]; w2[j] = p.in[I_CONVW][2048 + c0 + j]; }
        const int nchunk = NT >> 7, RC = (M + nchunk - 1) / nchunk, rbeg = (gt >> 7) * RC, rend = rbeg + RC < M ? rbeg + RC : M;
#define CV_UNPK(dst, ZV) do { const u32x4 zv_ = (ZV); dst[0] = bflo(zv_.x); dst[1] = bfhi(zv_.x); dst[2] = bflo(zv_.y); dst[3] = bfhi(zv_.y); dst[4] = bflo(zv_.z); dst[5] = bfhi(zv_.z); dst[6] = bflo(zv_.w); dst[7] = bfhi(zv_.w); } while (0)
        float xm1[8], xm2[8];
#pragma unroll
        for (int j = 0; j < 8; ++j) { xm1[j] = 0.f; xm2[j] = 0.f; }
        if (rbeg < rend) {
            if (rbeg >= 1) { const u32x4 z = *(const u32x4*)(CIN + (size_t)(rbeg - 1) * 1024 + c0); CV_UNPK(xm1, z); }
            if (rbeg >= 2) { const u32x4 z = *(const u32x4*)(CIN + (size_t)(rbeg - 2) * 1024 + c0); CV_UNPK(xm2, z); }
        }
        for (int r4 = rbeg; r4 < rend; r4 += 4) {
            u32x4 cz[4], bz[4];
#pragma unroll
            for (int k = 0; k < 4; ++k) { const int r = r4 + k < rend ? r4 + k : rend - 1; cz[k] = *(const u32x4*)(CIN + (size_t)r * 1024 + c0); bz[k] = *(const u32x4*)(BG + (size_t)r * 1024 + c0); }
#pragma unroll
            for (int k = 0; k < 4; ++k) { const int r = r4 + k; if (r < rend) {
                float x0[8], bg[8]; CV_UNPK(x0, cz[k]); CV_UNPK(bg, bz[k]);
                int i, bb; const bool prompt = r < MP;
                if (prompt) { bb = r / LP; i = r - bb * LP; } else { bb = (r - MP) >> 5; i = (r - MP) & 31; }
                if (i == 0) {
#pragma unroll
                    for (int j = 0; j < 8; ++j) { xm1[j] = prompt ? 0.f : p.in[I_CCONV][((size_t)bb * 2 + 1) * 1024 + c0 + j]; xm2[j] = prompt ? 0.f : p.in[I_CCONV][((size_t)bb * 2) * 1024 + c0 + j]; } }
                else if (i == 1) {
#pragma unroll
                    for (int j = 0; j < 8; ++j) xm2[j] = prompt ? 0.f : p.in[I_CCONV][((size_t)bb * 2 + 1) * 1024 + c0 + j]; }
                float o[8];
#pragma unroll
                for (int j = 0; j < 8; ++j) o[j] = bg[j] * (w0[j] * xm2[j] + w1[j] * xm1[j] + w2[j] * x0[j]);
                u32x4 w; w.x = pk2(o[0], o[1]); w.y = pk2(o[2], o[3]); w.z = pk2(o[4], o[5]); w.w = pk2(o[6], o[7]);
                *(u32x4*)(BG + (size_t)r * 1024 + c0) = w;
                const int L = prompt ? LP : DS;
                if (i >= L - 2) { float* op = p.out + (prompt ? OUT_NCP : OUT_NCS) + ((size_t)bb * 2 + (i - (L - 2))) * 1024 + c0;
                    *(f32x4*)op = (f32x4){x0[0], x0[1], x0[2], x0[3]}; *(f32x4*)(op + 4) = (f32x4){x0[4], x0[5], x0[6], x0[7]}; }
#pragma unroll
                for (int j = 0; j < 8; ++j) { xm2[j] = xm1[j]; xm1[j] = x0[j]; } } }
        }
#undef CV_UNPK
    }
}

#define MFMA32(a, b, c) __builtin_amdgcn_mfma_f32_32x32x16_bf16((a), (b), (c), 0, 0, 0)
constexpr int KROW_B = 208, VROW_B = 136, KBUF_B = 64 * KROW_B, VBUF_B = 64 * VROW_B, ABUF_B = KBUF_B + VBUF_B;
template <bool FAST> DI void attn_body(const Params& p, LAS unsigned char* lds, int hh, float m0) {
    unsigned char* ws = p.ws;
    const int tid = threadIdx.x, wid = __builtin_amdgcn_readfirstlane(tid >> 6), lane = tid & 63, q = lane & 31, hl = lane >> 5;
    const bf16_t* QR = (const bf16_t*)(ws + OFF_QR); const bf16_t* KH = (const bf16_t*)(ws + OFF_KH); const bf16_t* VT = (const bf16_t*)(ws + OFF_VT);
    bf16_t* ATT = (bf16_t*)(ws + OFF_ATT); const f32x2* rot = (const f32x2*)(ws + OFF_ROT); const float* qg = p.in[I_QN];
    const int kp_row = tid / 12, kp_c = tid - kp_row * 12, kp2 = 512 + tid, kp2_row = kp2 / 12, kp2_c = kp2 - kp2_row * 12;
    const int v_row = tid >> 3, v_c = tid & 7;
    const int vbk = (int)*(volatile LAS unsigned*)(lds + 131072 + 8);
    for (int ii = 0; ii < 9; ++ii) {
        int b, h, kb, vt0, ntile, qrow = -1, nvalid = 0, nk = 0, pos0 = 0, kind, g = 0, idx;
        { const int x = vbk & 7, r = vbk >> 3, grp = r >> 3, j = r & 7;
          if (ii < 8) { kind = 0; idx = x * 16 + (ii >> 1) * 4 + grp; g = (ii & 1) ? j : 15 - j; }
          else if (r < 16) { kind = 1; idx = x * 16 + r; }
          else { kind = 2; idx = x * 16 + (r - 16); } }
        b = idx >> 3; h = idx & 7;
        if (kind == 0) { const int c = 4 * g + (wid >> 1), i0 = 16 + 64 * c + 32 * (wid & 1); qrow = b * LP + i0; nvalid = 32; nk = 64 * c + 80; pos0 = i0; kb = b * LP; vt0 = b * 65; ntile = 4 * g + 5; }
        else if (kind == 1) { kb = MP + b * LSK; vt0 = 16 * 65 + b * 33; ntile = 33;
            if (wid == 0) { qrow = MP + b * DS; nvalid = 32; nk = LSK; pos0 = 16 + PAST; } }
        else { kb = b * LP; vt0 = b * 65; ntile = 1;
            if (wid == 0) { qrow = b * LP; nvalid = 16; nk = 16; pos0 = 0; } }
        const int hg = 8 * hh + h, ntw = (nk + 63) >> 6;
        bf16x8 qf[6];
#pragma unroll
        for (int s = 0; s < 6; ++s) qf[s] = (bf16x8){0, 0, 0, 0, 0, 0, 0, 0};
        if (qrow >= 0) {
            const bf16_t* qp = QR + (size_t)(qrow + q) * 1536 + hg * 96 + 8 * hl;
            float x[6][8]; float ss = 0.f;
#pragma unroll
            for (int s = 0; s < 6; ++s) { const u32x4 z = *(const u32x4*)(qp + 16 * s);
                x[s][0] = bflo(z.x); x[s][1] = bfhi(z.x); x[s][2] = bflo(z.y); x[s][3] = bfhi(z.y); x[s][4] = bflo(z.z); x[s][5] = bfhi(z.z); x[s][6] = bflo(z.w); x[s][7] = bfhi(z.w);
#pragma unroll
                for (int e = 0; e < 8; ++e) ss += x[s][e] * x[s][e]; }
            ss += __shfl_xor(ss, 32);
            const float rs = __builtin_amdgcn_rsqf(ss * (1.0f / 96.0f) + EPS) * (0.10206207261596575f * 1.4426950408889634f);
            const f32x2* rp = rot + (size_t)(pos0 + q) * 16 + 8 * hl;
#pragma unroll
            for (int e = 0; e < 8; ++e) { const f32x2 cs = rp[e]; const float a = x[4][e], bb = x[5][e]; x[4][e] = a * cs.x - bb * cs.y; x[5][e] = bb * cs.x + a * cs.y; }
#pragma unroll
            for (int s = 0; s < 6; ++s) { const f32x4 g0 = *(const f32x4*)(qg + 16 * s + 8 * hl), g1 = *(const f32x4*)(qg + 16 * s + 8 * hl + 4);
                u32x4 w; w.x = pk2(x[s][0] * g0[0] * rs, x[s][1] * g0[1] * rs); w.y = pk2(x[s][2] * g0[2] * rs, x[s][3] * g0[3] * rs);
                w.z = pk2(x[s][4] * g1[0] * rs, x[s][5] * g1[1] * rs); w.w = pk2(x[s][6] * g1[2] * rs, x[s][7] * g1[3] * rs);
                qf[s] = __builtin_bit_cast(bf16x8, w); }
        }
        const bf16_t* kbase = KH + ((size_t)h * MKP + kb) * 96 + tid * 8;
        const bf16_t* vbase = VT + (((size_t)h * NVT + vt0) << 12) + tid * 8;
        u32x4 kr0, kr1 = (u32x4){0, 0, 0, 0}, vr;
        kr0 = *(const u32x4*)(kbase);
        if (tid < 256) kr1 = *(const u32x4*)(kbase + 4096);
        vr = *(const u32x4*)(vbase);
        *(LAS u32x4*)(lds + kp_row * KROW_B + kp_c * 16) = kr0;
        if (tid < 256) *(LAS u32x4*)(lds + kp2_row * KROW_B + kp2_c * 16) = kr1;
        *(LAS u32x2*)(lds + KBUF_B + v_row * VROW_B + v_c * 16) = (u32x2){vr.x, vr.y}; *(LAS u32x2*)(lds + KBUF_B + v_row * VROW_B + v_c * 16 + 8) = (u32x2){vr.z, vr.w};
        __syncthreads();
        float mrun = -1e30f, lrun = 0.f;
        f32x16 o0, o1;
#pragma unroll
        for (int i = 0; i < 16; ++i) { o0[i] = 0.f; o1[i] = 0.f; }
        for (int t = 0; t < ntile; ++t) {
            const bool more = (t + 1 < ntile);
            if (more) { const size_t ko = (size_t)(t + 1) * 6144;
                kr0 = *(const u32x4*)(kbase + ko);
                if (tid < 256) kr1 = *(const u32x4*)(kbase + ko + 4096);
                vr = *(const u32x4*)(vbase + (size_t)(t + 1) * 4096); }
            if (t < ntw) {
                const LAS unsigned char* Kb = lds + (t & 1) * ABUF_B; const LAS unsigned char* Vb = Kb + KBUF_B;
                f32x16 s0, s1;
#pragma unroll
                for (int i = 0; i < 16; ++i) { s0[i] = FAST ? -m0 : 0.f; s1[i] = FAST ? -m0 : 0.f; }
#pragma unroll
                for (int s = 0; s < 6; ++s) {
                    const bf16x8 k0 = *(const LAS bf16x8*)(Kb + q * KROW_B + s * 32 + hl * 16);
                    const bf16x8 k1 = *(const LAS bf16x8*)(Kb + (q + 32) * KROW_B + s * 32 + hl * 16);
                    s0 = MFMA32(k0, qf[s], s0); s1 = MFMA32(k1, qf[s], s1);
                }
                if (64 * (t + 1) > nk) {
#pragma unroll
                    for (int i = 0; i < 16; ++i) { const int key = 64 * t + (i & 3) + 8 * (i >> 2) + 4 * hl; if (key >= nk) s0[i] = -1e30f; if (key + 32 >= nk) s1[i] = -1e30f; }
                }
                float ps = 0.f;
                if (FAST) {
#pragma unroll
                    for (int i = 0; i < 16; ++i) { s0[i] = __builtin_amdgcn_exp2f(s0[i]); s1[i] = __builtin_amdgcn_exp2f(s1[i]); ps += s0[i] + s1[i]; }
                    lrun += ps;
                } else {
                    float mx = fmaxf(s0[0], s1[0]);
#pragma unroll
                    for (int i = 1; i < 16; ++i) mx = fmaxf(mx, fmaxf(s0[i], s1[i]));
                    mx = fmaxf(mx, __shfl_xor(mx, 32));
                    const float mn = fmaxf(mrun, mx), alpha = __builtin_amdgcn_exp2f(mrun - mn); mrun = mn;
#pragma unroll
                    for (int i = 0; i < 16; ++i) { s0[i] = __builtin_amdgcn_exp2f(s0[i] - mn); s1[i] = __builtin_amdgcn_exp2f(s1[i] - mn); ps += s0[i] + s1[i]; }
                    lrun = lrun * alpha + ps;
#pragma unroll
                    for (int i = 0; i < 16; ++i) { o0[i] *= alpha; o1[i] *= alpha; }
                }
#pragma unroll
                for (int kb2 = 0; kb2 < 2; ++kb2)
#pragma unroll
                    for (int s2 = 0; s2 < 2; ++s2) {
                        u32x4 pw;
                        if (kb2 == 0) { pw.x = pk2(s0[8 * s2 + 0], s0[8 * s2 + 1]); pw.y = pk2(s0[8 * s2 + 2], s0[8 * s2 + 3]); pw.z = pk2(s0[8 * s2 + 4], s0[8 * s2 + 5]); pw.w = pk2(s0[8 * s2 + 6], s0[8 * s2 + 7]); }
                        else { pw.x = pk2(s1[8 * s2 + 0], s1[8 * s2 + 1]); pw.y = pk2(s1[8 * s2 + 2], s1[8 * s2 + 3]); pw.z = pk2(s1[8 * s2 + 4], s1[8 * s2 + 5]); pw.w = pk2(s1[8 * s2 + 6], s1[8 * s2 + 7]); }
                        const bf16x8 pf = __builtin_bit_cast(bf16x8, pw);
                        const int kofs = (32 * kb2 + 16 * s2 + 4 * hl) * 2;
                        const u32x2 a0 = *(const LAS u32x2*)(Vb + q * VROW_B + kofs), a1 = *(const LAS u32x2*)(Vb + q * VROW_B + kofs + 16);
                        const u32x2 c0 = *(const LAS u32x2*)(Vb + (q + 32) * VROW_B + kofs), c1 = *(const LAS u32x2*)(Vb + (q + 32) * VROW_B + kofs + 16);
                        o0 = MFMA32(__builtin_bit_cast(bf16x8, ((u32x4){a0.x, a0.y, a1.x, a1.y})), pf, o0);
                        o1 = MFMA32(__builtin_bit_cast(bf16x8, ((u32x4){c0.x, c0.y, c1.x, c1.y})), pf, o1);
                    }
            }
            if (more) { LAS unsigned char* nb = lds + ((t + 1) & 1) * ABUF_B;
                *(LAS u32x4*)(nb + kp_row * KROW_B + kp_c * 16) = kr0;
                if (tid < 256) *(LAS u32x4*)(nb + kp2_row * KROW_B + kp2_c * 16) = kr1;
                *(LAS u32x2*)(nb + KBUF_B + v_row * VROW_B + v_c * 16) = (u32x2){vr.x, vr.y}; *(LAS u32x2*)(nb + KBUF_B + v_row * VROW_B + v_c * 16 + 8) = (u32x2){vr.z, vr.w}; }
            __syncthreads();
        }
        if (qrow >= 0) {
            const float inv = 1.0f / (lrun + __shfl_xor(lrun, 32));
            if (q < nvalid) { bf16_t* op = ATT + (size_t)(qrow + q) * 1024 + hg * 64 + 4 * hl;
#pragma unroll
                for (int ig = 0; ig < 4; ++ig) {
                    st_bf4(op + 8 * ig, (f32x4){o0[4 * ig] * inv, o0[4 * ig + 1] * inv, o0[4 * ig + 2] * inv, o0[4 * ig + 3] * inv});
                    st_bf4(op + 32 + 8 * ig, (f32x4){o1[4 * ig] * inv, o1[4 * ig + 1] * inv, o1[4 * ig + 2] * inv, o1[4 * ig + 3] * inv}); } }
        }
    }
}
DI void load_q(const bf16_t* QR, const f32x2* rot, const float* qg, int qrow, int hg, int pos0, int q, int hl, bf16x8 (&qf)[6]) {
    const bf16_t* qp = QR + (size_t)(qrow + q) * 1536 + hg * 96 + 8 * hl;
    float x[6][8]; float ss = 0.f;
#pragma unroll
    for (int s = 0; s < 6; ++s) { const u32x4 z = *(const u32x4*)(qp + 16 * s);
        x[s][0] = bflo(z.x); x[s][1] = bfhi(z.x); x[s][2] = bflo(z.y); x[s][3] = bfhi(z.y); x[s][4] = bflo(z.z); x[s][5] = bfhi(z.z); x[s][6] = bflo(z.w); x[s][7] = bfhi(z.w);
#pragma unroll
        for (int e = 0; e < 8; ++e) ss += x[s][e] * x[s][e]; }
    ss += __shfl_xor(ss, 32);
    const float rs = __builtin_amdgcn_rsqf(ss * (1.0f / 96.0f) + EPS) * (0.10206207261596575f * 1.4426950408889634f);
    const f32x2* rp = rot + (size_t)(pos0 + q) * 16 + 8 * hl;
#pragma unroll
    for (int e = 0; e < 8; ++e) { const f32x2 cs = rp[e]; const float a = x[4][e], bb = x[5][e]; x[4][e] = a * cs.x - bb * cs.y; x[5][e] = bb * cs.x + a * cs.y; }
#pragma unroll
    for (int s = 0; s < 6; ++s) { const f32x4 g0 = *(const f32x4*)(qg + 16 * s + 8 * hl), g1 = *(const f32x4*)(qg + 16 * s + 8 * hl + 4);
        u32x4 w; w.x = pk2(x[s][0] * g0[0] * rs, x[s][1] * g0[1] * rs); w.y = pk2(x[s][2] * g0[2] * rs, x[s][3] * g0[3] * rs);
        w.z = pk2(x[s][4] * g1[0] * rs, x[s][5] * g1[1] * rs); w.w = pk2(x[s][6] * g1[2] * rs, x[s][7] * g1[3] * rs);
        qf[s] = __builtin_bit_cast(bf16x8, w); }
}
DI void attn_sample(const Params& p, LAS unsigned char* lds, int hh, float m0, int b, int h) {
    unsigned char* ws = p.ws;
    const int tid = threadIdx.x, wid = __builtin_amdgcn_readfirstlane(tid >> 6), lane = tid & 63, q = lane & 31, hl = lane >> 5;
    const bf16_t* KH = (const bf16_t*)(ws + OFF_KH); const bf16_t* VT = (const bf16_t*)(ws + OFF_VT); bf16_t* ATT = (bf16_t*)(ws + OFF_ATT);
    const int kb = MP + b * LSK, vt0 = 16 * 65 + b * 33, qrow = MP + b * DS, hg = 8 * hh + h, nk = LSK;
    bf16x8 qf[6];
    load_q((const bf16_t*)(ws + OFF_QR), (const f32x2*)(ws + OFF_ROT), p.in[I_QN], qrow, hg, 16 + PAST, q, hl, qf);
    f32x16 c0, c1; float lsum = 0.f;
#pragma unroll
    for (int i = 0; i < 16; ++i) { c0[i] = 0.f; c1[i] = 0.f; }
    for (int t = wid; t < 33; t += 8) {
        const bf16_t* kp = KH + ((size_t)h * MKP + kb + 64 * t + q) * 96 + 8 * hl;
        const bf16_t* vp = VT + (((size_t)h * NVT + vt0 + t) << 12) + q * 64 + 4 * hl;
        f32x16 x0, x1;
#pragma unroll
        for (int i = 0; i < 16; ++i) { x0[i] = -m0; x1[i] = -m0; }
        { bf16x8 k0[6];
#pragma unroll
          for (int s_ = 0; s_ < 6; ++s_) k0[s_] = *(const bf16x8*)(kp + 16 * s_);
#pragma unroll
          for (int s_ = 0; s_ < 6; ++s_) x0 = MFMA32(k0[s_], qf[s_], x0); }
        { bf16x8 k1[6];
#pragma unroll
          for (int s_ = 0; s_ < 6; ++s_) k1[s_] = *(const bf16x8*)(kp + 32 * 96 + 16 * s_);
#pragma unroll
          for (int s_ = 0; s_ < 6; ++s_) x1 = MFMA32(k1[s_], qf[s_], x1); }
        u32x2 va[4][2], vc[4][2];
#pragma unroll
        for (int f_ = 0; f_ < 4; ++f_) { va[f_][0] = *(const u32x2*)(vp + 16 * f_); va[f_][1] = *(const u32x2*)(vp + 16 * f_ + 8);
            vc[f_][0] = *(const u32x2*)(vp + 32 * 64 + 16 * f_); vc[f_][1] = *(const u32x2*)(vp + 32 * 64 + 16 * f_ + 8); }
        if (64 * (t + 1) > nk) {
#pragma unroll
            for (int i = 0; i < 16; ++i) { const int key = 64 * t + (i & 3) + 8 * (i >> 2) + 4 * hl; if (key >= nk) x0[i] = -1e30f; if (key + 32 >= nk) x1[i] = -1e30f; } }
        float ps = 0.f;
#pragma unroll
        for (int i = 0; i < 16; ++i) { x0[i] = __builtin_amdgcn_exp2f(x0[i]); x1[i] = __builtin_amdgcn_exp2f(x1[i]); ps += x0[i] + x1[i]; }
        lsum += ps;
#pragma unroll
        for (int s2 = 0; s2 < 2; ++s2) { u32x4 pw;
            pw.x = pk2(x0[8 * s2 + 0], x0[8 * s2 + 1]); pw.y = pk2(x0[8 * s2 + 2], x0[8 * s2 + 3]); pw.z = pk2(x0[8 * s2 + 4], x0[8 * s2 + 5]); pw.w = pk2(x0[8 * s2 + 6], x0[8 * s2 + 7]);
            const bf16x8 p0 = __builtin_bit_cast(bf16x8, pw);
            pw.x = pk2(x1[8 * s2 + 0], x1[8 * s2 + 1]); pw.y = pk2(x1[8 * s2 + 2], x1[8 * s2 + 3]); pw.z = pk2(x1[8 * s2 + 4], x1[8 * s2 + 5]); pw.w = pk2(x1[8 * s2 + 6], x1[8 * s2 + 7]);
            const bf16x8 p1 = __builtin_bit_cast(bf16x8, pw);
            c0 = MFMA32(__builtin_bit_cast(bf16x8, ((u32x4){va[s2][0].x, va[s2][0].y, va[s2][1].x, va[s2][1].y})), p0, c0);
            c1 = MFMA32(__builtin_bit_cast(bf16x8, ((u32x4){vc[s2][0].x, vc[s2][0].y, vc[s2][1].x, vc[s2][1].y})), p0, c1);
            c0 = MFMA32(__builtin_bit_cast(bf16x8, ((u32x4){va[2 + s2][0].x, va[2 + s2][0].y, va[2 + s2][1].x, va[2 + s2][1].y})), p1, c0);
            c1 = MFMA32(__builtin_bit_cast(bf16x8, ((u32x4){vc[2 + s2][0].x, vc[2 + s2][0].y, vc[2 + s2][1].x, vc[2 + s2][1].y})), p1, c1); }
    }
    LAS float* red = (LAS float*)lds;
#pragma unroll
    for (int i = 0; i < 16; ++i) { red[(wid * 33 + i) * 64 + lane] = c0[i]; red[(wid * 33 + 16 + i) * 64 + lane] = c1[i]; }
    red[(wid * 33 + 32) * 64 + lane] = lsum;
    asm volatile("s_waitcnt lgkmcnt(0)" ::: "memory"); __builtin_amdgcn_s_barrier(); asm volatile("" ::: "memory");
    if (wid == 0) {
#pragma unroll 1
        for (int w = 1; w < 8; ++w) {
#pragma unroll
            for (int i = 0; i < 16; ++i) { c0[i] += red[(w * 33 + i) * 64 + lane]; c1[i] += red[(w * 33 + 16 + i) * 64 + lane]; }
            lsum += red[(w * 33 + 32) * 64 + lane]; }
        const float inv = 1.0f / (lsum + __shfl_xor(lsum, 32));
        bf16_t* op = ATT + (size_t)(qrow + q) * 1024 + hg * 64 + 4 * hl;
#pragma unroll
        for (int ig = 0; ig < 4; ++ig) {
            st_bf4(op + 8 * ig, (f32x4){c0[4 * ig] * inv, c0[4 * ig + 1] * inv, c0[4 * ig + 2] * inv, c0[4 * ig + 3] * inv});
            st_bf4(op + 32 + 8 * ig, (f32x4){c1[4 * ig] * inv, c1[4 * ig + 1] * inv, c1[4 * ig + 2] * inv, c1[4 * ig + 3] * inv}); }
    }
    asm volatile("s_waitcnt lgkmcnt(0)" ::: "memory"); __builtin_amdgcn_s_barrier(); asm volatile("" ::: "memory");
}
DI void attn_pp(const Params& p, LAS unsigned char* lds, int hh, float m0) {
    unsigned char* ws = p.ws;
    const int tid = threadIdx.x, wid = __builtin_amdgcn_readfirstlane(tid >> 6), lane = tid & 63, q = lane & 31, hl = lane >> 5;
    const bool grpB = wid >= 4;
    const bf16_t* QR = (const bf16_t*)(ws + OFF_QR); const bf16_t* KH = (const bf16_t*)(ws + OFF_KH); const bf16_t* VT = (const bf16_t*)(ws + OFF_VT);
    bf16_t* ATT = (bf16_t*)(ws + OFF_ATT); const f32x2* rot = (const f32x2*)(ws + OFF_ROT); const float* qg = p.in[I_QN];
    const int kp_row = tid / 12, kp_c = tid - kp_row * 12, kp2 = 512 + tid, kp2_row = kp2 / 12, kp2_c = kp2 - kp2_row * 12;
    const int v_row = tid >> 3, v_c = tid & 7;
#define APP_BAR() do { asm volatile("s_waitcnt lgkmcnt(0)" ::: "memory"); __builtin_amdgcn_s_barrier(); asm volatile("" ::: "memory"); } while (0)
    const int vbk = (int)*(volatile LAS unsigned*)(lds + 131072 + 8);
    for (int ii = 0; ii < 9; ++ii) {
        int b, h, kb, vt0, ntile, qrow = -1, nvalid = 0, nk = 0, pos0 = 0, kind, g = 0, idx;
        { const int x = vbk & 7, r = vbk >> 3, grp = r >> 3, j = r & 7;
          if (ii < 8) { kind = 0; idx = x * 16 + (ii >> 1) * 4 + grp; g = (ii & 1) ? j : 15 - j; }
          else if (r < 16) { kind = 1; idx = x * 16 + r; }
          else { kind = 2; idx = x * 16 + (r - 16); } }
        if (kind == 1) { attn_sample(p, lds, hh, m0, idx >> 3, idx & 7); continue; }
        b = idx >> 3; h = idx & 7;
        if (kind == 0) { const int c = 4 * g + (wid >> 1), i0 = 16 + 64 * c + 32 * (wid & 1); qrow = b * LP + i0; nvalid = 32; nk = 64 * c + 80; pos0 = i0; kb = b * LP; vt0 = b * 65; ntile = 4 * g + 5; }
        else if (kind == 1) { kb = MP + b * LSK; vt0 = 16 * 65 + b * 33; ntile = 33;
            if (wid == 0) { qrow = MP + b * DS; nvalid = 32; nk = LSK; pos0 = 16 + PAST; } }
        else { kb = b * LP; vt0 = b * 65; ntile = 1;
            if (wid == 0) { qrow = b * LP; nvalid = 16; nk = 16; pos0 = 0; } }
        const int hg = 8 * hh + h, ntw = qrow >= 0 ? (nk + 63) >> 6 : 0;
        const bf16_t* kbase = KH + ((size_t)h * MKP + kb) * 96 + tid * 8;
        const bf16_t* vbase = VT + (((size_t)h * NVT + vt0) << 12) + tid * 8;
        u32x4 ka0 = (u32x4){0, 0, 0, 0}, ka1 = ka0, va = ka0, kb0 = ka0, kb1 = ka0, vb = ka0;
#define APP_LOAD(K0, K1, V, tK, tV) do { if ((tK) < ntile) { const size_t ko_ = (size_t)(tK) * 6144; K0 = *(const u32x4*)(kbase + ko_); \
            if (tid < 256) K1 = *(const u32x4*)(kbase + ko_ + 4096); } if ((tV) < ntile) V = *(const u32x4*)(vbase + (size_t)(tV) * 4096); } while (0)
#define APP_WRITE(K0, K1, V, tK, tV) do { if ((tK) < ntile) { LAS unsigned char* kd_ = lds + ((tK) & 1) * ABUF_B; *(LAS u32x4*)(kd_ + kp_row * KROW_B + kp_c * 16) = K0; \
            if (tid < 256) *(LAS u32x4*)(kd_ + kp2_row * KROW_B + kp2_c * 16) = K1; } \
            if ((tV) < ntile) { LAS unsigned char* vd_ = lds + ((tV) & 1) * ABUF_B + KBUF_B + v_row * VROW_B + v_c * 16; *(LAS u32x2*)vd_ = (u32x2){V.x, V.y}; *(LAS u32x2*)(vd_ + 8) = (u32x2){V.z, V.w}; } } while (0)
        APP_LOAD(ka0, ka1, va, 0, ntile);
        APP_LOAD(kb0, kb1, vb, 1, 0);
        bf16x8 qf[6];
#pragma unroll
        for (int s = 0; s < 6; ++s) qf[s] = (bf16x8){0, 0, 0, 0, 0, 0, 0, 0};
        if (qrow >= 0) {
            const bf16_t* qp = QR + (size_t)(qrow + q) * 1536 + hg * 96 + 8 * hl;
            float x[6][8]; float ss = 0.f;
#pragma unroll
            for (int s = 0; s < 6; ++s) { const u32x4 z = *(const u32x4*)(qp + 16 * s);
                x[s][0] = bflo(z.x); x[s][1] = bfhi(z.x); x[s][2] = bflo(z.y); x[s][3] = bfhi(z.y); x[s][4] = bflo(z.z); x[s][5] = bfhi(z.z); x[s][6] = bflo(z.w); x[s][7] = bfhi(z.w);
#pragma unroll
                for (int e = 0; e < 8; ++e) ss += x[s][e] * x[s][e]; }
            ss += __shfl_xor(ss, 32);
            const float rs = __builtin_amdgcn_rsqf(ss * (1.0f / 96.0f) + EPS) * (0.10206207261596575f * 1.4426950408889634f);
            const f32x2* rp = rot + (size_t)(pos0 + q) * 16 + 8 * hl;
#pragma unroll
            for (int e = 0; e < 8; ++e) { const f32x2 cs = rp[e]; const float a = x[4][e], bb = x[5][e]; x[4][e] = a * cs.x - bb * cs.y; x[5][e] = bb * cs.x + a * cs.y; }
#pragma unroll
            for (int s = 0; s < 6; ++s) { const f32x4 g0 = *(const f32x4*)(qg + 16 * s + 8 * hl), g1 = *(const f32x4*)(qg + 16 * s + 8 * hl + 4);
                u32x4 w; w.x = pk2(x[s][0] * g0[0] * rs, x[s][1] * g0[1] * rs); w.y = pk2(x[s][2] * g0[2] * rs, x[s][3] * g0[3] * rs);
                w.z = pk2(x[s][4] * g1[0] * rs, x[s][5] * g1[1] * rs); w.w = pk2(x[s][6] * g1[2] * rs, x[s][7] * g1[3] * rs);
                qf[s] = __builtin_bit_cast(bf16x8, w); }
        }
        APP_WRITE(ka0, ka1, va, 0, ntile);
        APP_LOAD(ka0, ka1, va, 2, 1);
        APP_BAR();
        if (grpB) APP_BAR();
        float lrun = 0.f;
        f32x16 o0, o1, s0, s1, cinit;
#pragma unroll
        for (int i = 0; i < 16; ++i) cinit[i] = -m0;
        bf16x8 pf[4];
#pragma unroll
        for (int i = 0; i < 16; ++i) { o0[i] = 0.f; o1[i] = 0.f; s0[i] = 0.f; s1[i] = 0.f; }
#pragma unroll
        for (int i = 0; i < 4; ++i) pf[i] = (bf16x8){0, 0, 0, 0, 0, 0, 0, 0};
#define APP_Z(tt) do { const LAS unsigned char* Vb = lds + ((tt) & 1) * ABUF_B + KBUF_B + q * VROW_B + 8 * hl; \
            u32x2 va_[4][2], vc_[4][2]; \
            _Pragma("unroll") for (int f = 0; f < 4; ++f) { va_[f][0] = *(const LAS u32x2*)(Vb + f * 32); va_[f][1] = *(const LAS u32x2*)(Vb + f * 32 + 16); \
                vc_[f][0] = *(const LAS u32x2*)(Vb + 32 * VROW_B + f * 32); vc_[f][1] = *(const LAS u32x2*)(Vb + 32 * VROW_B + f * 32 + 16); } \
            __builtin_amdgcn_sched_barrier(0); \
            _Pragma("unroll") for (int f = 0; f < 4; ++f) { \
                o0 = MFMA32(__builtin_bit_cast(bf16x8, ((u32x4){va_[f][0].x, va_[f][0].y, va_[f][1].x, va_[f][1].y})), pf[f], o0); \
                o1 = MFMA32(__builtin_bit_cast(bf16x8, ((u32x4){vc_[f][0].x, vc_[f][0].y, vc_[f][1].x, vc_[f][1].y})), pf[f], o1); } } while (0)
#define APP_X(tt) do { const LAS unsigned char* Kb = lds + ((tt) & 1) * ABUF_B + q * KROW_B + hl * 16; \
            { const bf16x8 k0 = *(const LAS bf16x8*)(Kb); const bf16x8 k1 = *(const LAS bf16x8*)(Kb + 32 * KROW_B); \
              s0 = MFMA32(k0, qf[0], cinit); s1 = MFMA32(k1, qf[0], cinit); } \
            _Pragma("unroll") for (int s = 1; s < 6; ++s) { \
                const bf16x8 k0 = *(const LAS bf16x8*)(Kb + s * 32); \
                const bf16x8 k1 = *(const LAS bf16x8*)(Kb + 32 * KROW_B + s * 32); \
                s0 = MFMA32(k0, qf[s], s0); s1 = MFMA32(k1, qf[s], s1); } } while (0)
#define APP_Y(tt) do { if (64 * ((tt) + 1) > nk) { \
                _Pragma("unroll") for (int i = 0; i < 16; ++i) { const int key = 64 * (tt) + (i & 3) + 8 * (i >> 2) + 4 * hl; if (key >= nk) s0[i] = -1e30f; if (key + 32 >= nk) s1[i] = -1e30f; } } \
            float ps = 0.f; \
            _Pragma("unroll") for (int i = 0; i < 16; ++i) { s0[i] = __builtin_amdgcn_exp2f(s0[i]); s1[i] = __builtin_amdgcn_exp2f(s1[i]); ps += s0[i] + s1[i]; } \
            lrun += ps; \
            _Pragma("unroll") for (int s2 = 0; s2 < 2; ++s2) { u32x4 pw; \
                pw.x = pk2(s0[8 * s2 + 0], s0[8 * s2 + 1]); pw.y = pk2(s0[8 * s2 + 2], s0[8 * s2 + 3]); pw.z = pk2(s0[8 * s2 + 4], s0[8 * s2 + 5]); pw.w = pk2(s0[8 * s2 + 6], s0[8 * s2 + 7]); \
                pf[s2] = __builtin_bit_cast(bf16x8, pw); \
                pw.x = pk2(s1[8 * s2 + 0], s1[8 * s2 + 1]); pw.y = pk2(s1[8 * s2 + 2], s1[8 * s2 + 3]); pw.z = pk2(s1[8 * s2 + 4], s1[8 * s2 + 5]); pw.w = pk2(s1[8 * s2 + 6], s1[8 * s2 + 7]); \
                pf[2 + s2] = __builtin_bit_cast(bf16x8, pw); } } while (0)
#define APP_STEP(tt, K0, K1, V) do { \
            if ((tt) > 0 && (tt) - 1 < ntw) APP_Z((tt) - 1); \
            if ((tt) < ntw) APP_X(tt); \
            if (grpB) { APP_WRITE(K0, K1, V, (tt) + 1, (tt)); APP_LOAD(K0, K1, V, (tt) + 3, (tt) + 2); } \
            APP_BAR(); \
            if ((tt) < ntw) APP_Y(tt); \
            if (!grpB) { APP_WRITE(K0, K1, V, (tt) + 1, (tt)); APP_LOAD(K0, K1, V, (tt) + 3, (tt) + 2); } \
            APP_BAR(); } while (0)
        for (int t = 0; t < ntile; t += 2) {
            APP_STEP(t, kb0, kb1, vb);
            if (t + 1 < ntile) APP_STEP(t + 1, ka0, ka1, va);
        }
        if (ntile - 1 < ntw) APP_Z(ntile - 1);
        if (qrow >= 0) {
            const float inv = 1.0f / (lrun + __shfl_xor(lrun, 32));
            if (q < nvalid) { bf16_t* op = ATT + (size_t)(qrow + q) * 1024 + hg * 64 + 4 * hl;
#pragma unroll
                for (int ig = 0; ig < 4; ++ig) {
                    st_bf4(op + 8 * ig, (f32x4){o0[4 * ig] * inv, o0[4 * ig + 1] * inv, o0[4 * ig + 2] * inv, o0[4 * ig + 3] * inv});
                    st_bf4(op + 32 + 8 * ig, (f32x4){o1[4 * ig] * inv, o1[4 * ig + 1] * inv, o1[4 * ig + 2] * inv, o1[4 * ig + 3] * inv}); } }
        }
        if (!grpB) APP_BAR();
    }
#undef APP_BAR
#undef APP_LOAD
#undef APP_WRITE
#undef APP_Z
#undef APP_X
#undef APP_Y
#undef APP_STEP
}
DI void attn_phase(const Params& p, LAS unsigned char* lds, int hh) {
    const int lane = threadIdx.x & 63;
    float mq = fmaxf(fabsf(p.in[I_QN][lane]), lane < 32 ? fabsf(p.in[I_QN][64 + lane]) : 0.f), mk = fmaxf(fabsf(p.in[I_KN][lane]), lane < 32 ? fabsf(p.in[I_KN][64 + lane]) : 0.f);
#pragma unroll
    for (int o = 1; o < 64; o <<= 1) { mq = fmaxf(mq, __shfl_xor(mq, o)); mk = fmaxf(mk, __shfl_xor(mk, o)); }
    const float m0 = 96.0f * 0.10206207261596575f * 1.4426950408889634f * 1.02f * mq * mk;
    if (m0 < 40.0f) attn_pp(p, lds, hh, m0); else attn_body<false>(p, lds, hh, 0.f);
}
DI void kv_half(const Params& p, LAS unsigned char* lds, int hh) {
    unsigned char* ws = p.ws;
    int K128 = 128; asm volatile("" : "+s"(K128));
    EpiK ek{(bf16_t*)(ws + OFF_KH), (const bf16_t*)(ws + OFF_KPE), p.in[I_KN]};
    run_gemm(lds, (const bf16_t*)(ws + OFF_CKV), (const bf16_t*)(ws + OFF_WK) + (size_t)hh * 512 * 128, MK, 512, K128, ek, 0);
    EpiVt ev{(bf16_t*)(ws + OFF_VT)};
    run_gemm(lds, (const bf16_t*)(ws + OFF_WVT) + (size_t)hh * 512 * 128, (const bf16_t*)(ws + OFF_CKV), 512, MK, K128, ev, 6);
}

constexpr int NPHASE = 17;
#ifndef ONLY
#define ONLY -1
#endif
#ifndef REP_PH
#define REP_PH -1
#endif
#ifndef REP_CNT
#define REP_CNT 1
#endif
#define PHASE(n, ...) if ((ONLY < 0 || ONLY == (n)) && p.ph_lo <= (n) && (n) < p.ph_hi) { \
    for (int rep_ = 0; rep_ < ((n) == REP_PH ? REP_CNT : 1); ++rep_) { __VA_ARGS__ if ((n) == REP_PH && rep_ + 1 < REP_CNT) xcd_barrier(xb); } \
    if ((n) + 1 < p.ph_hi) { if ((n) == 0) cg::this_grid().sync(); else xcd_barrier(xb); } }
DI void ph_swiglu(const Params& p, LAS unsigned char* lds, size_t woff) {
    EpiSwiglu e{(bf16_t*)(p.ws + OFF_ACT)};
    run_gemm(lds, (const bf16_t*)(p.ws + OFF_H), (const bf16_t*)(p.ws + woff), M, 5632, 1024, e, 0);
}
DI void tail_final(const Params& p) {
    const int lane = threadIdx.x & 63; const float* P = (const float*)(p.ws + OFF_ATT);
    for (int r = M_MAIN + blockIdx.x * 8 + (threadIdx.x >> 6); r < M; r += gridDim.x * 8) { f32x4 t[4]; tail_sum(P, r, 11, lane, t); float* xd = xrow_dst(p, r);
#pragma unroll
        for (int j = 0; j < 4; ++j) { const f32x4 x = *(const f32x4*)(xd + 4 * (lane + 64 * j)); *(f32x4*)(xd + 4 * (lane + 64 * j)) = x + 0.5f * t[j]; } }
}
DI void ph_resid(const Params& p, LAS unsigned char* lds, size_t aoff, size_t woff, int K, int src0, float scale) {
    EpiResid e{p.in[I_XP], p.in[I_META], p.in[I_XS], p.out, (float*)(p.ws + OFF_XM), src0, scale};
    run_gemm(lds, (const bf16_t*)(p.ws + aoff), (const bf16_t*)(p.ws + woff), M_MAIN, 1024, K, e, 0);
    EpiPartial ep{(float*)(p.ws + OFF_ATT)};
    int KS = 256; asm volatile("" : "+s"(KS));
    const int vb = (int)*(volatile LAS unsigned*)(lds + 131072 + 8);
    pg8::Gemm g{(const bf16_t*)(p.ws + aoff), (const bf16_t*)(p.ws + woff), M, 1024, KS, K};
    pg8::TailOrder T; T.pm0 = M_MAIN / 256; T.npm = NTAILP; T.nN = 4; T.S = K / 256; T.G = (int)gridDim.x; T.c = (vb + 100) % (int)gridDim.x;
    pg8::gemm_phase<EpiPartial, pg8::TailOrder>(lds, g, T, ep);
}
__global__ __launch_bounds__(512, 2) void mega(Params p) {
    extern __shared__ __attribute__((aligned(16))) unsigned char shm[];
    LAS unsigned char* lds = (LAS unsigned char*)shm;
    unsigned char* ws = p.ws;
    XcdBarrier xb; xb.bar = (unsigned*)(ws + OFF_BAR); xb.x = xb_xcc_id(); xb.st = (volatile LAS unsigned*)(lds + 131072);
    if (threadIdx.x == 0) { xb.st[0] = 0u; xb.st[1] = 0u; const unsigned rank = xb_add(&xb.bar[XB_XCNT(xb.x)], 1u); xb.st[2] = blockIdx.x; xb.st[3] = rank; }
    __syncthreads();
    PHASE(0, phase_prep(p, lds);)
    if (threadIdx.x == 0) {
        bool even = (gridDim.x % 8u) == 0u;
        for (unsigned j = 0; j < 16; ++j) { const unsigned c = xb_ld(&xb.bar[XB_XCNT(j)]); even = even && (c == (j < 8u ? gridDim.x / 8u : 0u)); }
        if (even && p.ph_lo == 0 && p.ph_hi > 1) xb.st[2] = xb.st[3] * 8u + xb.x;
    }
    __syncthreads();
    PHASE(1, ph_swiglu(p, lds, OFF_W1GU);)
    PHASE(2, ph_resid(p, lds, OFF_ACT, OFF_W1D, 2816, 1, 0.5f);)
    PHASE(3, norm_rows(p, 0, p.in[I_MIXN], (bf16_t*)(ws + OFF_H), 11, 0.5f, 1);)
    PHASE(4, { EpiInProj e{(bf16_t*)(ws + OFF_BG), (bf16_t*)(ws + OFF_CIN), (bf16_t*)(ws + OFF_GC), (bf16_t*)(ws + OFF_GM), (bf16_t*)(ws + OFF_ZQ), (float*)(ws + OFF_ZL)};
            run_gemm(lds, (const bf16_t*)(ws + OFF_H), (const bf16_t*)(ws + OFF_WIN), M, NIN, 1024, e, 0); })
    PHASE(5, phase_lat_conv(p);)
    PHASE(6, { EpiGate e{(bf16_t*)(ws + OFF_H), (const bf16_t*)(ws + OFF_GC), nullptr};
            run_gemm(lds, (const bf16_t*)(ws + OFF_BG), (const bf16_t*)(ws + OFF_WCO), M, 1024, 1024, e, 0); })
    PHASE(7, {  EpiQup e{(bf16_t*)(ws + OFF_QR), (const float*)(ws + OFF_RQ)};
                run_gemm(lds, (const bf16_t*)(ws + OFF_ZQ), (const bf16_t*)(ws + OFF_WUQ), M, 1536, 384, e, 0);
                const int gt = blockIdx.x * 512 + threadIdx.x; const int NT = gridDim.x * 512;
                for (int i = gt; i < 8 * 768; i += NT) *(u32x4*)(ws + OFF_KH + (((size_t)(i / 768) * MKP + MK) * 96) * 2 + (size_t)(i % 768) * 16) = (u32x4){0, 0, 0, 0};
                for (int i = gt; i < 8 * 32 * 64 * 16; i += NT) { const int c4 = i & 15, d = (i >> 4) & 63, sq = (i >> 10) & 31, hh_ = i >> 15;
                    const int tile = sq < 16 ? sq * 65 + 64 : 16 * 65 + (sq - 16) * 33 + 32, j0 = sq < 16 ? 16 : 32;
                    if (c4 * 4 >= j0) *(u32x2*)(ws + OFF_VT + (((((size_t)hh_ * NVT + tile) * 64 + d) << 6) + c4 * 4) * 2) = (u32x2){0, 0}; }
                kv_half(p, lds, 0); })
    PHASE(8, attn_phase(p, lds, 0);)
    PHASE(9, kv_half(p, lds, 1);)
    PHASE(10, attn_phase(p, lds, 1);)
    PHASE(11, { EpiGate e{(bf16_t*)(ws + OFF_MG), (const bf16_t*)(ws + OFF_GM), (const bf16_t*)(ws + OFF_H)};
            run_gemm(lds, (const bf16_t*)(ws + OFF_ATT), (const bf16_t*)(ws + OFF_WMO), M, 1024, 1024, e, 0); })
    PHASE(12, ph_resid(p, lds, OFF_MG, OFF_WOUT, 1024, 0, 1.0f);)
    PHASE(13, norm_rows(p, 0, p.in[I_F2N], (bf16_t*)(ws + OFF_H), 4, 1.0f, 0);)
    PHASE(14, ph_swiglu(p, lds, OFF_W2GU);)
    PHASE(15, ph_resid(p, lds, OFF_ACT, OFF_W2D, 2816, 0, 0.5f);)
    PHASE(16, tail_final(p);)
}

constexpr int LDS_BYTES = 131072 + 16;
extern "C" void kernel_launch(void* const* d_in, const int* in_sizes, int n_in, void* d_out, int out_size, void* d_ws, size_t ws_size, hipStream_t stream) {
    static int grid = 0;
    if (grid == 0) {
        if (n_in != 26 || ws_size < WS_END) { fprintf(stderr, "kernel_launch: need 26 inputs and %zu bytes of workspace (got %d, %zu)\n", (size_t)WS_END, n_in, ws_size); grid = -1; return; }
        int dev = 0, cus = 0, per_cu = 0;
        if (hipGetDevice(&dev) != hipSuccess || hipDeviceGetAttribute(&cus, hipDeviceAttributeMultiprocessorCount, dev) != hipSuccess) { grid = -1; return; }
        if (hipFuncSetAttribute((const void*)mega, hipFuncAttributeMaxDynamicSharedMemorySize, LDS_BYTES) != hipSuccess) { fprintf(stderr, "kernel_launch: hipFuncSetAttribute failed\n"); grid = -1; return; }
        if (hipOccupancyMaxActiveBlocksPerMultiprocessor(&per_cu, (const void*)mega, 512, LDS_BYTES) != hipSuccess || per_cu < 1) { fprintf(stderr, "kernel_launch: occupancy query says %d\n", per_cu); per_cu = 1; }
        (void)hipGetLastError();
        if (cus != 256) { fprintf(stderr, "kernel_launch: built for a 256-CU device (got %d)\n", cus); grid = -1; return; }
        grid = 256;
    }
    if (grid < 0) return;
    if (hipMemsetAsync((char*)d_ws + OFF_BAR, 0, XCD_BAR_WORDS * 4, stream) != hipSuccess) { fprintf(stderr, "kernel_launch: memset failed\n"); return; }
    Params p{};
    for (int i = 0; i < 26; ++i) p.in[i] = (const float*)d_in[i];
    p.out = (float*)d_out; p.ws = (unsigned char*)d_ws;
#if N_LAUNCH_MODE == 1
    p.ph_lo = 0; p.ph_hi = NPHASE;
    void* args[] = {&p};
    hipError_t e = hipLaunchCooperativeKernel((const void*)mega, dim3(grid), dim3(512), args, LDS_BYTES, stream);
    if (e != hipSuccess) fprintf(stderr, "cooperative launch failed: %s (grid %d)\n", hipGetErrorString(e), grid);
#else
    for (int ph = 0; ph < NPHASE; ++ph) { p.ph_lo = ph; p.ph_hi = ph + 1; hipLaunchKernelGGL(mega, dim3(grid), dim3(512), LDS_BYTES, stream, p); }
#endif
}
```

```cpp
#include <hip/hip_runtime.h>
#include <hip/hip_cooperative_groups.h>
#include <cstdio>
namespace cg = cooperative_groups;

#ifndef N_LAUNCH_MODE
#define N_LAUNCH_MODE 1
#endif

#define LAS __attribute__((address_space(3)))
#define DI __device__ __forceinline__
typedef unsigned short bf16_t;
typedef short bf16x8 __attribute__((ext_vector_type(8)));
typedef float f32x4 __attribute__((ext_vector_type(4)));
typedef float f32x2 __attribute__((ext_vector_type(2)));
typedef float f32x16 __attribute__((ext_vector_type(16)));
typedef unsigned u32x4 __attribute__((ext_vector_type(4)));
typedef unsigned u32x2 __attribute__((ext_vector_type(2)));
typedef __bf16 bf16v2 __attribute__((ext_vector_type(2)));

constexpr int D = 1024, FF = 2816, NB = 16, LP = 4112, DS = 32, PAST = 2048;
constexpr int MP = NB * LP;
constexpr int MS = NB * DS;
constexpr int M = MP + MS;
constexpr int LSK = PAST + DS;
constexpr int MK = MP + NB * LSK;
constexpr int MKP = MK + 64;
constexpr int NIN = 5888;
constexpr float EPS = 1e-6f;

constexpr size_t OFF_W1GU = 0;
constexpr size_t OFF_W1D = OFF_W1GU + (size_t)5632 * 1024 * 2;
constexpr size_t OFF_WIN = OFF_W1D + (size_t)1024 * 2816 * 2;
constexpr size_t OFF_WUQ = OFF_WIN + (size_t)NIN * 1024 * 2;
constexpr size_t OFF_WK = OFF_WUQ + (size_t)1536 * 384 * 2;
constexpr size_t OFF_WVT = OFF_WK + (size_t)1024 * 256 * 2;
constexpr size_t OFF_WCO = OFF_WVT + (size_t)1024 * 256 * 2;
constexpr size_t OFF_WMO = OFF_WCO + (size_t)1024 * 1024 * 2;
constexpr size_t OFF_WOUT = OFF_WMO + (size_t)1024 * 1024 * 2;
constexpr size_t OFF_W2GU = OFF_WOUT + (size_t)1024 * 1024 * 2;
constexpr size_t OFF_W2D = OFF_W2GU + (size_t)5632 * 1024 * 2;
constexpr size_t OFF_ROT = OFF_W2D + (size_t)1024 * 2816 * 2;
constexpr size_t OFF_RQ = OFF_ROT + (size_t)LP * 16 * 8;
constexpr size_t OFF_XM = OFF_RQ + (size_t)M * 4;
constexpr size_t OFF_BAR = OFF_XM + (size_t)256 * 1024 * 4;
constexpr size_t RB = (size_t)60 << 20;
static_assert(OFF_BAR + 16384 <= RB, "weights region overflow");
static_assert(OFF_XM % 16 == 0 && OFF_RQ % 16 == 0 && OFF_ROT % 16 == 0, "align");
constexpr size_t EU = (size_t)M * 256;
constexpr size_t OFF_H = RB + 0 * EU;
constexpr size_t OFF_GM = RB + 8 * EU;
constexpr size_t OFF_ZQ = RB + 16 * EU;
constexpr size_t OFF_CKV = RB + 19 * EU;
constexpr size_t OFF_KPE = RB + 22 * EU;
constexpr size_t OFF_BG = RB + 23 * EU;
constexpr size_t OFF_CIN = RB + 31 * EU;
constexpr size_t OFF_GC = RB + 39 * EU;
constexpr size_t OFF_ZL = RB + 47 * EU;
constexpr size_t OFF_QR = RB + 23 * EU;
constexpr size_t OFF_KH = RB + 35 * EU;
constexpr size_t OFF_VT = RB + 44 * EU;
constexpr size_t OFF_ATT = RB + 51 * EU;
constexpr size_t OFF_MG = RB + 35 * EU;
constexpr size_t OFF_ACT = RB + 8 * EU;
constexpr size_t WS_END = RB + 59 * EU;
static_assert((size_t)MKP * 256 * 2 <= 3 * EU && (size_t)MKP * 32 * 2 <= EU && (size_t)M * 160 * 4 <= 3 * EU, "region sizes");
constexpr int NVT = 16 * 65 + 16 * 33;
static_assert((size_t)MKP * 768 * 2 <= 9 * EU && (size_t)8 * NVT * 4096 * 2 <= 7 * EU, "kv region sizes");

constexpr size_t OUT_YP = 0;
constexpr size_t OUT_YS = OUT_YP + (size_t)NB * 4096 * 1024;
constexpr size_t OUT_NCP = OUT_YS + (size_t)MS * 1024;
constexpr size_t OUT_KVP = OUT_NCP + (size_t)NB * 2 * 1024;
constexpr size_t OUT_KRP = OUT_KVP + (size_t)MP * 128;
constexpr size_t OUT_NCS = OUT_KRP + (size_t)MP * 32;
constexpr size_t OUT_KVS = OUT_NCS + (size_t)NB * 2 * 1024;
constexpr size_t OUT_KRS = OUT_KVS + (size_t)MS * 128;

struct Params {
    const float* in[26];
    float* out;
    unsigned char* ws;
    int ph_lo, ph_hi;
};
enum { I_XP = 0, I_XS, I_CCONV, I_CKV, I_CKR, I_META, I_F1N, I_F1G, I_F1U, I_F1D, I_MIXN, I_WIN, I_CONVW, I_WCO, I_QAN, I_WUQ, I_KVAN, I_WUKV, I_QN, I_KN, I_WMO, I_WOUT, I_F2N, I_F2G, I_F2U, I_F2D };

DI unsigned pk2(float a, float b) { bf16v2 v = __builtin_convertvector((f32x2){a, b}, bf16v2); return __builtin_bit_cast(unsigned, v); }
DI float bflo(unsigned u) { return __uint_as_float(u << 16); }
DI float bfhi(unsigned u) { return __uint_as_float(u & 0xffff0000u); }
DI float wave_sum(float v) {
#pragma unroll
    for (int o = 1; o < 64; o <<= 1) v += __shfl_xor(v, o);
    return v;
}
DI float* xrow_dst(const Params& p, int r) {
    if (r < MP) { const int b = r / LP, i = r - b * LP;
        if (i >= 16) return p.out + OUT_YP + ((size_t)b * 4096 + (i - 16)) * 1024;
        return (float*)(p.ws + OFF_XM) + (size_t)(b * 16 + i) * 1024; }
    return p.out + OUT_YS + (size_t)(r - MP) * 1024;
}
DI const float* xrow_src0(const Params& p, int r) {
    if (r < MP) { const int b = r / LP, i = r - b * LP;
        if (i >= 16) return p.in[I_XP] + ((size_t)b * 4096 + (i - 16)) * 1024;
        return p.in[I_META] + (size_t)i * 1024; }
    return p.in[I_XS] + (size_t)(r - MP) * 1024;
}


#define XB_TMO      128
#define XB_XCNT(j)  (256  + 64 * (j))
#define XB_XSUB(j)  (1280 + 64 * (j))
#define XB_XGEN(j)  (2304 + 64 * (j))
#define XB_TOP      3328
#define XB_TOPGEN   3392
#define XCD_BAR_WORDS 3456
#define XB_SPIN_CAP (1u << 22)
DI unsigned xb_ld(unsigned* p) { return __hip_atomic_load(p, __ATOMIC_RELAXED, __HIP_MEMORY_SCOPE_AGENT); }
DI unsigned xb_add(unsigned* p, unsigned v) { return __hip_atomic_fetch_add(p, v, __ATOMIC_RELAXED, __HIP_MEMORY_SCOPE_AGENT); }
DI unsigned xb_xcc_id() { return (unsigned)__builtin_amdgcn_s_getreg((3 << 11) | 20) & 0xFu; }
#define XB_SPIN(cond, bar) do { unsigned _sp = 0; while (cond) { __builtin_amdgcn_s_sleep(1); \
    if ((++_sp & 255u) == 0u) { if (xb_ld(&(bar)[XB_TMO])) break; if (_sp > XB_SPIN_CAP) { atomicAdd(&(bar)[XB_TMO], 1u); break; } } } } while (0)
struct XcdBarrier { unsigned* bar; unsigned x; volatile LAS unsigned* st; };
DI void xcd_barrier_complete(unsigned* bar, unsigned x, unsigned& nloc, unsigned& nx) {
    const unsigned G = gridDim.x;
    unsigned sum, cnt, mine, sp = 0u;
    for (;;) {
        sum = 0u; cnt = 0u; mine = 0u;
#pragma unroll
        for (unsigned j = 0; j < 16; ++j) { const unsigned c = xb_ld(&bar[XB_XCNT(j)]); sum += c; cnt += (c > 0u) ? 1u : 0u; mine = (j == x) ? c : mine; }
        if (sum == G) break;
        __builtin_amdgcn_s_sleep(1);
        if ((++sp & 255u) == 0u) { if (xb_ld(&bar[XB_TMO])) break; if (sp > XB_SPIN_CAP) { atomicAdd(&bar[XB_TMO], 1u); break; } }
    }
    nloc = mine > 0u ? mine : 1u; nx = cnt > 0u ? cnt : 1u;
}
DI void xcd_barrier(const XcdBarrier& b) {
    asm volatile("s_waitcnt vmcnt(0)" ::: "memory");
    __syncthreads();
    if (threadIdx.x == 0) {
        unsigned* bar = b.bar;
        __builtin_amdgcn_s_waitcnt(0);
        unsigned nloc = b.st[0], nx = b.st[1];
        if (nloc == 0u) { xcd_barrier_complete(bar, b.x, nloc, nx); b.st[0] = nloc; b.st[1] = nx; }
        const unsigned old = xb_add(&bar[XB_XSUB(b.x)], 1u);
        const unsigned gen = old / nloc;
        if (old + 1u == (gen + 1u) * nloc) {
            __builtin_amdgcn_fence(__ATOMIC_RELEASE, "agent");
            asm volatile("s_waitcnt vmcnt(0)" ::: "memory");
            const unsigned og = xb_add(&bar[XB_TOP], 1u);
            const unsigned tg = og / nx;
            if (og + 1u == (tg + 1u) * nx) xb_add(&bar[XB_TOPGEN], 1u);
            else XB_SPIN(xb_ld(&bar[XB_TOPGEN]) == tg, bar);
            __builtin_amdgcn_fence(__ATOMIC_ACQUIRE, "agent");
            xb_add(&bar[XB_XGEN(b.x)], 1u);
            asm volatile("s_waitcnt vmcnt(0)" ::: "memory");
        } else {
            XB_SPIN(xb_ld(&bar[XB_XGEN(b.x)]) == gen, bar);
            __builtin_amdgcn_fence(__ATOMIC_ACQUIRE, "agent");
            asm volatile("s_waitcnt vmcnt(0)" ::: "memory");
        }
    }
    __syncthreads();
}

namespace pg8 {
constexpr int BM = 256, BK = 64, HALF = 128, HTB = HALF * BK * 2, STAGE_BYTES = 8 * HTB, NXCD = 8, WGM = 8;
DI int lds_byte(int r, int c) { const int st = (r >> 4) * 2 + (c >> 5), rr = r & 15, cc = c & 31, ob = rr * 64 + cc * 2; return st * 1024 + (ob ^ (((ob >> 9) & 1) << 5)); }
DI void stage_rc(int b, int& R, int& C) { const int st = b / 1024, sb = b % 1024, swz = sb ^ (((sb >> 9) & 1) << 5); R = (st >> 1) * 16 + swz / 64; C = (st & 1) * 32 + (swz % 64) / 2; }
struct Unit { int pm, pn, ks; };
struct Gemm { const bf16_t* A; const bf16_t* Bt; int M, N, K, ld; };
struct StaticOrder {
    int nM, nN, nwg, G, c;
    DI void init(int M_, int N_, int G_, int c_) { nM = M_ / BM; nN = N_ / BM; nwg = nM * nN; G = G_; c = c_; }
    DI bool next(int i, Unit& u) const {
        const long L = (long)i * G + c; if (L >= nwg) return false;
        int wgid = (int)L; { const int q = nwg / NXCD, r = nwg % NXCD, xcd = wgid % NXCD, off = wgid / NXCD; wgid = (xcd < r ? xcd * (q + 1) : r * (q + 1) + (xcd - r) * q) + off; }
        const int nig = WGM * nN, gid = wgid / nig, fm = gid * WGM, gsz = (nM - fm) < WGM ? (nM - fm) : WGM;
        u.pm = fm + ((wgid % nig) % gsz); u.pn = (wgid % nig) / gsz; u.ks = 0; return true;
    }
};
struct TailOrder {
    int pm0, npm, nN, S, G, c;
    DI bool next(int i, Unit& u) const {
        const long L = (long)i * G + c; if (L >= (long)npm * nN * S) return false;
        const int l = (int)L; u.ks = l % S; const int t = l / S; u.pn = t % nN; u.pm = pm0 + t / nN; return true;
    }
};
template <class Epi, class Sched>
DI void gemm_phase(LAS unsigned char* lds, const Gemm g, const Sched& S, const Epi& E) {
    const int tid = threadIdx.x, wid = __builtin_amdgcn_readfirstlane(tid >> 6), lane = tid & 63, wr = wid >> 2, wc = wid & 3, fr = lane & 15, fq = lane >> 4;
    const int K = g.K, nt = K / BK, ld = g.ld;
    unsigned voffA[2], voffB[2];
#pragma unroll
    for (int i = 0; i < 2; ++i) { int R, C; stage_rc(tid * 16 + i * 8192, R, C); voffA[i] = (unsigned)(R * ld + C) * 2u;
        const int r32 = R & 31, Rb = Epi::PERMB ? (R & ~31) + 8 * ((r32 >> 2) & 3) + 4 * (r32 >> 4) + (r32 & 3) : R; voffB[i] = (unsigned)(Rb * ld + C) * 2u; }
    const size_t kstep = (size_t)(BK * 2);
    const size_t hstep = (size_t)HALF * ld * 2;
    const size_t tstep = 2 * hstep;
    const unsigned ldsw = (unsigned)wid * 1024u;
    const int aoff = lds_byte(wr * 64 + fr, fq * 8), boff = lds_byte(wc * 32 + fr, fq * 8);
#define PG8_SA(b, h) (((b) * 2 + (h)) * HTB)
#define PG8_SB(b, h) ((4 + (b) * 2 + (h)) * HTB)
#define PG8_STAGE(bufoff, gbase, voff) do { _Pragma("unroll") for (int _i = 0; _i < 2; ++_i) \
        __builtin_amdgcn_global_load_lds((const unsigned*)((const char*)(gbase) + (voff)[_i]), (LAS unsigned*)(lds + (bufoff) + ldsw + _i * 8192), 16, 0, 0); } while (0)
#define PG8_LDA(dst, b, h) do { _Pragma("unroll") for (int m = 0; m < 4; ++m) _Pragma("unroll") for (int k = 0; k < 2; ++k) dst[m][k] = *(const LAS bf16x8*)(lds + PG8_SA(b, h) + aoff + m * 2048 + k * 1024); } while (0)
#define PG8_LDB(dst, b, h) do { _Pragma("unroll") for (int n = 0; n < 2; ++n) _Pragma("unroll") for (int k = 0; k < 2; ++k) dst[n][k] = *(const LAS bf16x8*)(lds + PG8_SB(b, h) + boff + n * 2048 + k * 1024); } while (0)
#define PG8_MMA(ai, bj, At, Bt) do { __builtin_amdgcn_s_setprio(1); _Pragma("unroll") for (int m = 0; m < 4; ++m) _Pragma("unroll") for (int n = 0; n < 2; ++n) _Pragma("unroll") for (int k = 0; k < 2; ++k) \
        acc[ai][bj][m][n] = __builtin_amdgcn_mfma_f32_16x16x32_bf16(Bt[n][k], At[m][k], acc[ai][bj][m][n], 0, 0, 0); __builtin_amdgcn_s_setprio(0); } while (0)
#define PG8_WAIT_V(n) asm volatile("s_waitcnt vmcnt(" #n ")" ::: "memory")
#define PG8_WAIT_L(n) asm volatile("s_waitcnt lgkmcnt(" #n ")" ::: "memory")
#define PG8_BAR __builtin_amdgcn_s_barrier()
#define PG8_SCHED __builtin_amdgcn_sched_barrier(0)
    Unit cur, nxt; int ui = 0;
    if (!S.next(0, cur)) return;
    f32x4 acc[2][2][4][2];
#pragma unroll
    for (int a = 0; a < 2; ++a)
#pragma unroll
        for (int b = 0; b < 2; ++b)
#pragma unroll
            for (int m = 0; m < 4; ++m)
#pragma unroll
                for (int n = 0; n < 2; ++n) acc[a][b][m][n] = (f32x4){0.f, 0.f, 0.f, 0.f};
    bf16x8 At[4][2], B0[2][2], B1[2][2];
    const char* cA = (const char*)g.A + (size_t)cur.pm * tstep + (size_t)cur.ks * K * 2; const char* cB = (const char*)g.Bt + (size_t)cur.pn * tstep + (size_t)cur.ks * K * 2;
    PG8_STAGE(PG8_SB(0, 0), cB, voffB); PG8_STAGE(PG8_SA(0, 0), cA, voffA); PG8_STAGE(PG8_SB(0, 1), cB + hstep, voffB); PG8_STAGE(PG8_SA(0, 1), cA + hstep, voffA);
    if (wr == 1) PG8_BAR;
    PG8_WAIT_V(4); PG8_BAR;
    PG8_STAGE(PG8_SB(1, 0), cB + kstep, voffB); PG8_STAGE(PG8_SA(1, 0), cA + kstep, voffA); PG8_STAGE(PG8_SB(1, 1), cB + hstep + kstep, voffB);
    PG8_WAIT_V(6); PG8_BAR;
    for (;;) {
        const bool has_next = S.next(ui + 1, nxt);
        const char* nA = has_next ? (const char*)g.A + (size_t)nxt.pm * tstep + (size_t)nxt.ks * K * 2 : cA; const char* nB = has_next ? (const char*)g.Bt + (size_t)nxt.pn * tstep + (size_t)nxt.ks * K * 2 : cB;
#pragma unroll 1
        for (int t = 0; t < nt; t += 2) {
            const bool last = (t == nt - 2);
            const char* a1 = cA + (size_t)(t + 1) * kstep;
            const char* a2 = last ? nA : cA + (size_t)(t + 2) * kstep; const char* b2 = last ? nB : cB + (size_t)(t + 2) * kstep;
            const char* a3 = a2 + kstep; const char* b3 = b2 + kstep;
            PG8_LDB(B0, 0, 0); PG8_SCHED; PG8_LDA(At, 0, 0); PG8_STAGE(PG8_SA(1, 1), a1 + hstep, voffA);
            PG8_WAIT_L(8); PG8_BAR; PG8_WAIT_L(0); PG8_MMA(0, 0, At, B0); PG8_BAR; PG8_SCHED;
            PG8_LDB(B1, 0, 1); PG8_STAGE(PG8_SB(0, 0), b2, voffB);
            PG8_BAR; PG8_WAIT_L(0); PG8_MMA(0, 1, At, B1); PG8_BAR;
            PG8_LDA(At, 0, 1); PG8_STAGE(PG8_SA(0, 0), a2, voffA);
            PG8_BAR; PG8_WAIT_L(0); PG8_MMA(1, 0, At, B0); PG8_BAR; PG8_SCHED;
            PG8_STAGE(PG8_SB(0, 1), b2 + hstep, voffB);
            PG8_WAIT_V(6); PG8_BAR; PG8_MMA(1, 1, At, B1); PG8_BAR;
            PG8_LDB(B0, 1, 0); PG8_SCHED; PG8_LDA(At, 1, 0); PG8_STAGE(PG8_SA(0, 1), a2 + hstep, voffA);
            PG8_WAIT_L(8); PG8_BAR; PG8_WAIT_L(0); PG8_MMA(0, 0, At, B0); PG8_BAR; PG8_SCHED;
            PG8_LDB(B1, 1, 1); PG8_STAGE(PG8_SB(1, 0), b3, voffB);
            PG8_BAR; PG8_WAIT_L(0); PG8_MMA(0, 1, At, B1); PG8_BAR;
            PG8_LDA(At, 1, 1); PG8_STAGE(PG8_SA(1, 0), a3, voffA);
            PG8_BAR; PG8_WAIT_L(0); PG8_MMA(1, 0, At, B0); PG8_BAR; PG8_SCHED;
            PG8_STAGE(PG8_SB(1, 1), b3 + hstep, voffB);
            PG8_WAIT_V(6); PG8_BAR; PG8_MMA(1, 1, At, B1); PG8_BAR;
        }
        E(acc, cur, wr, wc, fr, fq);
        if (!has_next) break;
#pragma unroll
        for (int a = 0; a < 2; ++a)
#pragma unroll
            for (int b = 0; b < 2; ++b)
#pragma unroll
                for (int m = 0; m < 4; ++m)
#pragma unroll
                    for (int n = 0; n < 2; ++n) acc[a][b][m][n] = (f32x4){0.f, 0.f, 0.f, 0.f};
        cur = nxt; cA = nA; cB = nB; ++ui;
    }
    PG8_WAIT_V(0);
    if (wr == 0) PG8_BAR;
    PG8_BAR;
#undef PG8_SA
#undef PG8_SB
#undef PG8_STAGE
#undef PG8_LDA
#undef PG8_LDB
#undef PG8_MMA
#undef PG8_WAIT_V
#undef PG8_WAIT_L
#undef PG8_BAR
#undef PG8_SCHED
}
}
using pg8::Unit;
typedef f32x4 Acc[2][2][4][2];

DI int fresh_lane() { int l; asm volatile("v_mbcnt_lo_u32_b32 %0, -1, 0\n\tv_mbcnt_hi_u32_b32 %0, -1, %0" : "=v"(l)); return l; }
#define EPI_ROWS(ai, m) for (int ai = 0; ai < 2; ++ai) _Pragma("unroll") for (int m = 0; m < 4; ++m)
DI void st_bf4(bf16_t* p, f32x4 v) { u32x2 w; w.x = pk2(v[0], v[1]); w.y = pk2(v[2], v[3]); *(u32x2*)p = w; }
DI float sigm2(float x) { return __builtin_amdgcn_rcpf(1.0f + __builtin_amdgcn_exp2f(-x)); }

DI void st_bf8(bf16_t* p, f32x4 a, f32x4 b) { u32x4 w; w.x = pk2(a[0], a[1]); w.y = pk2(a[2], a[3]); w.z = pk2(b[0], b[1]); w.w = pk2(b[2], b[3]); *(u32x4*)p = w; }
struct EpiSwiglu {
    static constexpr bool PERMB = false;
    bf16_t* O;
    DI void operator()(const Acc& acc, const Unit& u, int wr, int wc, int fr_, int fq_) const {
        const int lane_ = fresh_lane(), fr = lane_ & 15, fq = lane_ >> 4;
        const int row0 = u.pm * 256 + wr * 64 + fr, col0 = u.pn * 128 + wc * 32 + 8 * fq;
#pragma unroll
        EPI_ROWS(ai, m) { bf16_t* rp = O + (size_t)(row0 + ai * 128 + m * 16) * FF + col0; f32x4 v[2];
#pragma unroll
            for (int n = 0; n < 2; ++n) { const f32x4 g = acc[ai][0][m][n], up = acc[ai][1][m][n];
#pragma unroll
                for (int j = 0; j < 4; ++j) v[n][j] = g[j] * up[j] * sigm2(g[j]); }
            st_bf8(rp, v[0], v[1]); }
    }
};
struct EpiResid {
    static constexpr bool PERMB = false;
    const float *xp, *meta, *xs; float* out; float* xm; int src0; float scale;
    DI float* drow(int r) const {
        if (r < MP) { const int b = r / LP, i = r - b * LP;
            if (i >= 16) return out + OUT_YP + ((size_t)b * 4096 + (i - 16)) * 1024;
            return xm + (size_t)(b * 16 + i) * 1024; }
        return out + OUT_YS + (size_t)(r - MP) * 1024; }
    DI const float* srow(int r) const {
        if (r < MP) { const int b = r / LP, i = r - b * LP;
            if (i >= 16) return xp + ((size_t)b * 4096 + (i - 16)) * 1024;
            return meta + (size_t)i * 1024; }
        return xs + (size_t)(r - MP) * 1024; }
    DI void operator()(const Acc& acc, const Unit& u, int wr, int wc, int fr_, int fq_) const {
        const int lane_ = fresh_lane(), fr = lane_ & 15, fq = lane_ >> 4;
        const int row0 = u.pm * 256 + wr * 64 + fr, col0 = u.pn * 256 + wc * 32 + 8 * fq;
        f32x4 xa[2][2][2], xb[2][2][2];
#define ER_LOAD(X, Q) do { _Pragma("unroll") for (int mm = 0; mm < 2; ++mm) { const int r_ = row0 + ((Q) >> 1) * 128 + (2 * ((Q) & 1) + mm) * 16; \
            const float* sp_ = (src0 ? srow(r_) : (const float*)drow(r_)) + col0; \
            _Pragma("unroll") for (int bj = 0; bj < 2; ++bj) _Pragma("unroll") for (int n = 0; n < 2; ++n) X[mm][bj][n] = *(const f32x4*)(sp_ + bj * 128 + n * 4); } } while (0)
#define ER_STORE(X, Q) do { _Pragma("unroll") for (int mm = 0; mm < 2; ++mm) { const int r_ = row0 + ((Q) >> 1) * 128 + (2 * ((Q) & 1) + mm) * 16; float* dp_ = drow(r_) + col0; \
            _Pragma("unroll") for (int bj = 0; bj < 2; ++bj) _Pragma("unroll") for (int n = 0; n < 2; ++n) \
                *(f32x4*)(dp_ + bj * 128 + n * 4) = X[mm][bj][n] + scale * acc[(Q) >> 1][bj][2 * ((Q) & 1) + mm][n]; } } while (0)
        ER_LOAD(xa, 0); ER_LOAD(xb, 1);
        ER_STORE(xa, 0); ER_LOAD(xa, 2);
        ER_STORE(xb, 1); ER_LOAD(xb, 3);
        ER_STORE(xa, 2); ER_STORE(xb, 3);
#undef ER_LOAD
#undef ER_STORE
    }
};
constexpr int M_MAIN = 65536, NTAILP = (M - M_MAIN) / 256;
struct EpiPartial {
    static constexpr bool PERMB = false;
    float* P;
    DI void operator()(const Acc& acc, const Unit& u, int wr, int wc, int fr_, int fq_) const {
        const int lane_ = fresh_lane(), fr = lane_ & 15, fq = lane_ >> 4;
        float* base = P + (size_t)((u.ks * NTAILP + (u.pm - M_MAIN / 256)) * 4 + u.pn) * 65536 + (size_t)(wr * 64 + fr) * 256 + wc * 32 + 8 * fq;
#pragma unroll
        EPI_ROWS(ai, m)
#pragma unroll
            for (int bj = 0; bj < 2; ++bj)
#pragma unroll
                for (int n = 0; n < 2; ++n) *(f32x4*)(base + (size_t)(ai * 128 + m * 16) * 256 + bj * 128 + n * 4) = acc[ai][bj][m][n];
    }
};
struct EpiInProj {
    static constexpr bool PERMB = false;
    bf16_t *BG, *CIN, *GC, *GM, *ZQ; float* ZL;
    DI void operator()(const Acc& acc, const Unit& u, int wr, int wc, int fr_, int fq_) const {
        const int lane_ = fresh_lane(), fr = lane_ & 15, fq = lane_ >> 4;
        const int row0 = u.pm * 256 + wr * 64 + fr, T = u.pn, cw = wc * 32 + 8 * fq;
        if (T >= 4 && T < 12) {
#pragma unroll
            EPI_ROWS(ai, m) st_bf8(CIN + (size_t)(row0 + ai * 128 + m * 16) * 1024 + (T - 4) * 128 + cw, acc[ai][0][m][0] * acc[ai][1][m][0], acc[ai][0][m][1] * acc[ai][1][m][1]);
        } else if (T < 4 || T == 20) {
            bf16_t* base = T < 4 ? BG + T * 256 : ZQ; const int ld = T < 4 ? 1024 : 384;
#pragma unroll
            EPI_ROWS(ai, m) { bf16_t* rp = base + (size_t)(row0 + ai * 128 + m * 16) * ld + cw;
#pragma unroll
                for (int bj = 0; bj < 2; ++bj) st_bf8(rp + bj * 128, acc[ai][bj][m][0], acc[ai][bj][m][1]); }
        } else if (T < 20) {
            bf16_t* base = T < 16 ? GC + (T - 12) * 256 : GM + (T - 16) * 256;
#pragma unroll
            EPI_ROWS(ai, m) { bf16_t* rp = base + (size_t)(row0 + ai * 128 + m * 16) * 1024 + cw;
#pragma unroll
                for (int bj = 0; bj < 2; ++bj) { f32x4 v[2];
#pragma unroll
                    for (int n = 0; n < 2; ++n)
#pragma unroll
                        for (int j = 0; j < 4; ++j) v[n][j] = sigm2(acc[ai][bj][m][n][j]);
                    st_bf8(rp + bj * 128, v[0], v[1]); } }
        } else if (T == 21) {
#pragma unroll
            EPI_ROWS(ai, m) { const size_t r = (size_t)(row0 + ai * 128 + m * 16);
                st_bf8(ZQ + r * 384 + 256 + cw, acc[ai][0][m][0], acc[ai][0][m][1]);
                *(f32x4*)(ZL + r * 160 + cw) = acc[ai][1][m][0]; *(f32x4*)(ZL + r * 160 + cw + 4) = acc[ai][1][m][1]; }
        } else {
            if (wc == 0) {
#pragma unroll
                EPI_ROWS(ai, m) { const size_t r = (size_t)(row0 + ai * 128 + m * 16);
                    *(f32x4*)(ZL + r * 160 + 128 + 8 * fq) = acc[ai][0][m][0]; *(f32x4*)(ZL + r * 160 + 128 + 8 * fq + 4) = acc[ai][0][m][1]; }
            }
        }
    }
};
struct EpiQup {
    static constexpr bool PERMB = false;
    bf16_t* O; const float* rq;
    DI void operator()(const Acc& acc, const Unit& u, int wr, int wc, int fr_, int fq_) const {
        const int lane_ = fresh_lane(), fr = lane_ & 15, fq = lane_ >> 4;
        const int row0 = u.pm * 256 + wr * 64 + fr, col0 = u.pn * 256 + wc * 32 + 8 * fq;
        float sc[2][4];
#pragma unroll
        for (int ai = 0; ai < 2; ++ai)
#pragma unroll
            for (int m = 0; m < 4; ++m) sc[ai][m] = rq[row0 + ai * 128 + m * 16];
#pragma unroll
        EPI_ROWS(ai, m) { const int r = row0 + ai * 128 + m * 16; const float s = sc[ai][m]; bf16_t* rp = O + (size_t)r * 1536 + col0;
#pragma unroll
            for (int bj = 0; bj < 2; ++bj) st_bf8(rp + bj * 128, acc[ai][bj][m][0] * s, acc[ai][bj][m][1] * s); }
    }
};
struct EpiGate {
    static constexpr bool PERMB = false;
    bf16_t* O; const bf16_t* gate; const bf16_t* add;
    DI void operator()(const Acc& acc, const Unit& u, int wr, int wc, int fr_, int fq_) const {
        const int lane_ = fresh_lane(), fr = lane_ & 15, fq = lane_ >> 4;
        const int row0 = u.pm * 256 + wr * 64 + fr, col0 = u.pn * 256 + wc * 32 + 8 * fq;
        u32x4 ga[2][2], aa[2][2], gb[2][2], ab[2][2];
#define EG_LOAD(G, A, Q) do { _Pragma("unroll") for (int mm = 0; mm < 2; ++mm) _Pragma("unroll") for (int bj = 0; bj < 2; ++bj) { \
            const size_t oo_ = (size_t)(row0 + ((Q) >> 1) * 128 + (2 * ((Q) & 1) + mm) * 16) * 1024 + col0 + bj * 128; \
            G[mm][bj] = *(const u32x4*)(gate + oo_); A[mm][bj] = add ? *(const u32x4*)(add + oo_) : (u32x4){0u, 0u, 0u, 0u}; } } while (0)
#define EG_STORE(G, A, Q) do { _Pragma("unroll") for (int mm = 0; mm < 2; ++mm) _Pragma("unroll") for (int bj = 0; bj < 2; ++bj) { \
            const size_t oo_ = (size_t)(row0 + ((Q) >> 1) * 128 + (2 * ((Q) & 1) + mm) * 16) * 1024 + col0 + bj * 128; \
            const u32x4 g = G[mm][bj], a2 = A[mm][bj]; const f32x4 a = acc[(Q) >> 1][bj][2 * ((Q) & 1) + mm][0], c = acc[(Q) >> 1][bj][2 * ((Q) & 1) + mm][1]; \
            st_bf8(O + oo_, (f32x4){bflo(a2.x) + bflo(g.x) * a[0], bfhi(a2.x) + bfhi(g.x) * a[1], bflo(a2.y) + bflo(g.y) * a[2], bfhi(a2.y) + bfhi(g.y) * a[3]}, \
                            (f32x4){bflo(a2.z) + bflo(g.z) * c[0], bfhi(a2.z) + bfhi(g.z) * c[1], bflo(a2.w) + bflo(g.w) * c[2], bfhi(a2.w) + bfhi(g.w) * c[3]}); } } while (0)
        EG_LOAD(ga, aa, 0); EG_LOAD(gb, ab, 1);
        EG_STORE(ga, aa, 0); EG_LOAD(ga, aa, 2);
        EG_STORE(gb, ab, 1); EG_LOAD(gb, ab, 3);
        EG_STORE(ga, aa, 2); EG_STORE(gb, ab, 3);
#undef EG_LOAD
#undef EG_STORE
    }
};
struct EpiK {
    static constexpr bool PERMB = false;
    bf16_t* K; const bf16_t* KPE; const float* kg_;
    DI void operator()(const Acc& acc, const Unit& u, int wr, int wc, int fr_, int fq_) const {
        const int lane_ = fresh_lane(), fr = lane_ & 15, fq = lane_ >> 4;
        const int row0 = u.pm * 256 + wr * 64 + fr, hl = 4 * u.pn + wc;
        const float* kg = kg_; asm volatile("" : "+s"(kg));
        f32x4 g[2][2]; f32x4 gr0 = *(const f32x4*)(kg + 64 + 8 * fq), gr1 = *(const f32x4*)(kg + 68 + 8 * fq);
#pragma unroll
        for (int bj = 0; bj < 2; ++bj)
#pragma unroll
            for (int n = 0; n < 2; ++n) g[bj][n] = *(const f32x4*)(kg + 32 * bj + 8 * fq + 4 * n);
        u32x4 kpv[2][4];
#pragma unroll
        for (int ai = 0; ai < 2; ++ai)
#pragma unroll
            for (int m = 0; m < 4; ++m) kpv[ai][m] = *(const u32x4*)(KPE + (size_t)(row0 + ai * 128 + m * 16) * 32 + 8 * fq);
#pragma unroll
        EPI_ROWS(ai, m) { const int r = row0 + ai * 128 + m * 16;
            const u32x4 kp = kpv[ai][m];
            f32x4 r0 = (f32x4){bflo(kp.x), bfhi(kp.x), bflo(kp.y), bfhi(kp.y)}, r1 = (f32x4){bflo(kp.z), bfhi(kp.z), bflo(kp.w), bfhi(kp.w)};
            float ss = 0.f;
#pragma unroll
            for (int j = 0; j < 4; ++j) ss += r0[j] * r0[j] + r1[j] * r1[j];
#pragma unroll
            for (int bj = 0; bj < 2; ++bj)
#pragma unroll
                for (int n = 0; n < 2; ++n) { const f32x4 a = acc[ai][bj][m][n]; ss += (a[0] * a[0] + a[1] * a[1]) + (a[2] * a[2] + a[3] * a[3]); }
            ss += __shfl_xor(ss, 16); ss += __shfl_xor(ss, 32);
            const float rs = __builtin_amdgcn_rsqf(ss * (1.0f / 96.0f) + EPS);
            bf16_t* kr = K + ((size_t)hl * MKP + r) * 96;
#pragma unroll
            for (int bj = 0; bj < 2; ++bj) st_bf8(kr + 32 * bj + 8 * fq, acc[ai][bj][m][0] * g[bj][0] * rs, acc[ai][bj][m][1] * g[bj][1] * rs);
            u32x4 w; r0 = r0 * gr0 * rs; r1 = r1 * gr1 * rs; w.x = pk2(r0[0], r0[1]); w.y = pk2(r0[2], r0[3]); w.z = pk2(r1[0], r1[1]); w.w = pk2(r1[2], r1[3]);
            *(u32x4*)(kr + 64 + 8 * fq) = w; }
    }
};
struct EpiVt {
    static constexpr bool PERMB = true;
    bf16_t* O;
    DI void operator()(const Acc& acc, const Unit& u, int wr, int wc, int fr_, int fq_) const {
        const int lane_ = fresh_lane(), fr = lane_ & 15, fq = lane_ >> 4;
        const int row0 = u.pm * 256 + wr * 64 + fr, col0 = u.pn * 256 + wc * 32 + 8 * fq;
#pragma unroll
        for (int bj = 0; bj < 2; ++bj) { const int r = col0 + bj * 128; int tile, j;
            if (r < MP) { const int b = r / LP, i = r - b * LP; tile = b * 65 + (i >> 6); j = i & 63; }
            else { const int r2 = r - MP, b = r2 / LSK, i = r2 - b * LSK; tile = 16 * 65 + b * 33 + (i >> 6); j = i & 63; }
#pragma unroll
            EPI_ROWS(ai, m) { const int row = row0 + ai * 128 + m * 16, hl = row >> 6, d = row & 63;
                st_bf8(O + ((((size_t)hl * NVT + tile) * 64 + d) << 6) + j, acc[ai][bj][m][0], acc[ai][bj][m][1]); } }
    }
};
template <class Epi> DI void run_gemm(LAS unsigned char* lds, const bf16_t* A, const bf16_t* Bt, int Mr, int N, int K, const Epi& E, int coff) {
    const int vb = (int)*(volatile LAS unsigned*)(lds + 131072 + 8);
    pg8::Gemm g{A, Bt, Mr, N, K, K}; pg8::StaticOrder S; S.init(Mr, N, (int)gridDim.x, (int)((vb + coff) % gridDim.x));
    pg8::gemm_phase<Epi, pg8::StaticOrder>(lds, g, S, E);
}

template <int KIND> DI float wval(const float* src, const float* qan, int np, int kp) {
    if (KIND == 0 || KIND == 2 || KIND == 3 || KIND == 4 || KIND == 6) { const int r = np & 31; np = (np & ~31) | (8 * ((r >> 2) & 3) + 4 * (r >> 4) + (r & 3)); }
    if (KIND == 6) return src[(size_t)kp * 1024 + np];
    if (KIND == 0) { const int T = np >> 8, e = np & 127; return src[(size_t)kp * FF + 128 * T + e] * (((np >> 7) & 1) ? 0.6931471805599453f : 1.4426950408889634f); }
    if (KIND == 1) return src[(size_t)kp * 1024 + np];
    if (KIND == 2) { const int T = np >> 8, r = np & 255; int col;
        if (T < 4) col = np;
        else if (T < 12) col = ((r >> 7) ? 2048 : 1024) + 128 * (T - 4) + (r & 127);
        else if (T < 16) col = 3616 + 256 * (T - 12) + r;
        else if (T < 20) col = 4640 + 256 * (T - 16) + r;
        else if (T == 20) col = 3072 + r;
        else if (T == 21) col = r < 128 ? 3072 + 256 + r : 3456 + (r - 128);
        else col = r < 32 ? 3584 + r : -1;
        return col < 0 ? 0.f : src[(size_t)kp * 5664 + col] * ((T >= 12 && T < 20) ? 1.4426950408889634f : 1.0f); }
    if (KIND == 3) return src[(size_t)kp * 1536 + np] * qan[kp];
    if (KIND == 4) { const int hh = np >> 9, pn = (np >> 8) & 1, bj = (np >> 7) & 1, wc = (np >> 5) & 3, e = np & 31; const int head = 8 * hh + 4 * pn + wc, dim = 32 * bj + e;
        return kp < 128 ? src[(size_t)kp * 2048 + head * 128 + dim] : 0.f; }
    return kp < 128 ? src[(size_t)kp * 2048 + (np >> 6) * 128 + 64 + (np & 63)] : 0.f;
}
template <int KIND> DI void wconv(const float* src, const float* src2, const float* qan, bf16_t* dst, int NP, int KP, LAS float* scr) {
    const int tid = threadIdx.x, nkt = KP >> 6, ntiles = (NP >> 6) * nkt;
    float cur[8], nxt[8];
#define WC_LOAD(dstv, tile_) do { const int ntl_ = (tile_) / nkt, kt_ = (tile_) - ntl_ * nkt, n0_ = ntl_ * 64, k0_ = kt_ * 64; \
        const float* sp_ = src; if (KIND == 0 && ((n0_ >> 7) & 1)) sp_ = src2; \
        _Pragma("unroll") for (int i = 0; i < 8; ++i) dstv[i] = wval<KIND>(sp_, qan, n0_ + (tid & 63), k0_ + (tid >> 6) + 8 * i); } while (0)
    int tile = blockIdx.x;
    if (tile < ntiles) WC_LOAD(cur, tile);
    for (; tile < ntiles; tile += gridDim.x) {
        const int ntl = tile / nkt, kt = tile - ntl * nkt, n0 = ntl * 64, k0 = kt * 64;
        const bool more = tile + (int)gridDim.x < ntiles;
        if (more) WC_LOAD(nxt, tile + (int)gridDim.x);
#pragma unroll
        for (int i = 0; i < 8; ++i) { const int kk = (tid >> 6) + 8 * i, nn = tid & 63; scr[kk * 65 + nn] = cur[i]; }
        __syncthreads();
#pragma unroll
        for (int i = 0; i < 8; ++i) { const int nn = (tid >> 6) + 8 * i, kk = tid & 63; dst[(size_t)(n0 + nn) * KP + k0 + kk] = (bf16_t)(pk2(scr[kk * 65 + nn], 0.f) & 0xffffu); }
        __syncthreads();
#pragma unroll
        for (int i = 0; i < 8; ++i) cur[i] = nxt[i];
    }
#undef WC_LOAD
}
DI void tail_sum(const float* P, int r, int S, int lane, f32x4 (&t)[4]) {
    const int pp = (r - M_MAIN) >> 8, rr = r & 255;
#pragma unroll
    for (int j = 0; j < 4; ++j) t[j] = (f32x4){0.f, 0.f, 0.f, 0.f};
    for (int s_ = 0; s_ < S; ++s_) {
#pragma unroll
        for (int j = 0; j < 4; ++j) t[j] += *(const f32x4*)(P + (size_t)((s_ * NTAILP + pp) * 4 + j) * 65536 + (size_t)rr * 256 + 4 * lane); }
}
DI void norm_rows(const Params& p, int from_src0, const float* gain, bf16_t* H, int tailS, float tscale, int tail_src0) {
    const int lane = threadIdx.x & 63, gw = blockIdx.x * 8 + (threadIdx.x >> 6), NGW = gridDim.x * 8;
    const float* P = (const float*)(p.ws + OFF_ATT);
    f32x4 gv[4];
#pragma unroll
    for (int j = 0; j < 4; ++j) gv[j] = *(const f32x4*)(gain + 4 * (lane + 64 * j));
    for (int r0 = gw; r0 < M; r0 += 4 * NGW) {
        f32x4 v[4][4]; float ss[4];
#pragma unroll
        for (int k = 0; k < 4; ++k) { const int r = r0 + k * NGW; const int rc = r < M ? r : r0; const bool tl = tailS > 0 && r >= M_MAIN && r < M; const float* x = (from_src0 || (tl && tail_src0)) ? xrow_src0(p, rc) : xrow_dst(p, rc);
#pragma unroll
            for (int j = 0; j < 4; ++j) v[k][j] = *(const f32x4*)(x + 4 * (lane + 64 * j));
            if (tl) { f32x4 t[4]; tail_sum(P, r, tailS, lane, t); float* xd = xrow_dst(p, r);
#pragma unroll
                for (int j = 0; j < 4; ++j) { v[k][j] += tscale * t[j]; *(f32x4*)(xd + 4 * (lane + 64 * j)) = v[k][j]; } } }
#pragma unroll
        for (int k = 0; k < 4; ++k) { float a = 0.f;
#pragma unroll
            for (int j = 0; j < 4; ++j) a += (v[k][j][0] * v[k][j][0] + v[k][j][1] * v[k][j][1]) + (v[k][j][2] * v[k][j][2] + v[k][j][3] * v[k][j][3]);
            ss[k] = a; }
#pragma unroll
        for (int o = 1; o < 64; o <<= 1) {
#pragma unroll
            for (int k = 0; k < 4; ++k) ss[k] += __shfl_xor(ss[k], o); }
#pragma unroll
        for (int k = 0; k < 4; ++k) { const int r = r0 + k * NGW; if (r < M) { const float rs = __builtin_amdgcn_rsqf(ss[k] * (1.0f / 1024.0f) + EPS);
#pragma unroll
            for (int j = 0; j < 4; ++j) st_bf4(H + (size_t)r * 1024 + 4 * (lane + 64 * j), v[k][j] * gv[j] * rs); } }
    }
}
DI void phase_prep(const Params& p, LAS unsigned char* lds) {
    unsigned char* ws = p.ws;
    LAS float* scr = (LAS float*)lds;
    wconv<0>(p.in[I_F1G], p.in[I_F1U], nullptr, (bf16_t*)(ws + OFF_W1GU), 5632, 1024, scr);
    wconv<6>(p.in[I_F1D], nullptr, nullptr, (bf16_t*)(ws + OFF_W1D), 1024, 2816, scr);
    wconv<2>(p.in[I_WIN], nullptr, nullptr, (bf16_t*)(ws + OFF_WIN), NIN, 1024, scr);
    wconv<3>(p.in[I_WUQ], nullptr, p.in[I_QAN], (bf16_t*)(ws + OFF_WUQ), 1536, 384, scr);
    wconv<4>(p.in[I_WUKV], nullptr, nullptr, (bf16_t*)(ws + OFF_WK), 1024, 128, scr);
    wconv<5>(p.in[I_WUKV], nullptr, nullptr, (bf16_t*)(ws + OFF_WVT), 1024, 128, scr);
    wconv<6>(p.in[I_WCO], nullptr, nullptr, (bf16_t*)(ws + OFF_WCO), 1024, 1024, scr);
    wconv<6>(p.in[I_WMO], nullptr, nullptr, (bf16_t*)(ws + OFF_WMO), 1024, 1024, scr);
    wconv<6>(p.in[I_WOUT], nullptr, nullptr, (bf16_t*)(ws + OFF_WOUT), 1024, 1024, scr);
    wconv<0>(p.in[I_F2G], p.in[I_F2U], nullptr, (bf16_t*)(ws + OFF_W2GU), 5632, 1024, scr);
    wconv<6>(p.in[I_F2D], nullptr, nullptr, (bf16_t*)(ws + OFF_W2D), 1024, 2816, scr);
    f32x2* rot = (f32x2*)(ws + OFF_ROT);
    for (int e = blockIdx.x * 512 + threadIdx.x; e < LP * 16; e += gridDim.x * 512) {
        const int pos = e >> 4, i = e & 15; double inv = 1.0;
        for (int k = 0; k < i; ++k) inv *= 0.56234132519034908;
        const double ang = (double)pos * inv; const double n = rint(ang * 0.15915494309189535);
        double r = fma(-n, 6.283185307179586, ang); r = fma(-n, 2.4492935982947064e-16, r);
        const double r2 = r * r; double tc = 1.0, sc = 1.0, tsn = r, ssn = r;
        for (int k = 1; k <= 14; ++k) { tc *= -r2 / (double)((2 * k - 1) * (2 * k)); sc += tc; tsn *= -r2 / (double)((2 * k) * (2 * k + 1)); ssn += tsn; }
        rot[e] = (f32x2){(float)sc, (float)ssn};
    }
    norm_rows(p, 1, p.in[I_F1N], (bf16_t*)(ws + OFF_H), 0, 0.f, 0);
}

DI void phase_lat_conv(const Params& p) {
    unsigned char* ws = p.ws;
    const int lane = threadIdx.x & 63, gw = blockIdx.x * 8 + (threadIdx.x >> 6), NGW = gridDim.x * 8;
    const float* ZL = (const float*)(ws + OFF_ZL); const bf16_t* ZQ = (const bf16_t*)(ws + OFF_ZQ);
    bf16_t* CKV = (bf16_t*)(ws + OFF_CKV); bf16_t* KPE = (bf16_t*)(ws + OFF_KPE); float* RQ = (float*)(ws + OFF_RQ);
    const f32x2* rot = (const f32x2*)(ws + OFF_ROT);
    const f32x4 gkv = *(const f32x4*)(p.in[I_KVAN] + 4 * (lane & 31));
    for (int r0 = gw; r0 < M; r0 += 4 * NGW) {
        f32x4 v[4]; float x1[4], x2[4]; f32x2 cs[4]; u32x4 zq[4]; int rr[4];
#pragma unroll
        for (int k = 0; k < 4; ++k) { const int r = r0 + k * NGW < M ? r0 + k * NGW : r0; rr[k] = r;
            const int pos = r < MP ? r % LP : 16 + PAST + ((r - MP) & 31);
            v[k] = (f32x4){0.f, 0.f, 0.f, 0.f}; x1[k] = 0.f; x2[k] = 0.f; cs[k] = (f32x2){0.f, 0.f}; zq[k] = (u32x4){0u, 0u, 0u, 0u};
            if (lane < 32) v[k] = *(const f32x4*)(ZL + (size_t)r * 160 + 4 * lane);
            if (lane < 16) { x1[k] = ZL[(size_t)r * 160 + 128 + lane]; x2[k] = ZL[(size_t)r * 160 + 144 + lane]; cs[k] = rot[pos * 16 + lane]; }
            if (lane < 48) zq[k] = *(const u32x4*)(ZQ + (size_t)r * 384 + 8 * lane); }
        float ss[4], sq[4];
#pragma unroll
        for (int k = 0; k < 4; ++k) { ss[k] = (v[k][0] * v[k][0] + v[k][1] * v[k][1]) + (v[k][2] * v[k][2] + v[k][3] * v[k][3]); const u32x4 z = zq[k];
            const float a0 = bflo(z.x), a1 = bfhi(z.x), a2 = bflo(z.y), a3 = bfhi(z.y), a4 = bflo(z.z), a5 = bfhi(z.z), a6 = bflo(z.w), a7 = bfhi(z.w);
            sq[k] = (a0 * a0 + a1 * a1) + (a2 * a2 + a3 * a3) + (a4 * a4 + a5 * a5) + (a6 * a6 + a7 * a7); }
#pragma unroll
        for (int o = 1; o < 64; o <<= 1) {
#pragma unroll
            for (int k = 0; k < 4; ++k) { ss[k] += __shfl_xor(ss[k], o); sq[k] += __shfl_xor(sq[k], o); } }
#pragma unroll
        for (int k = 0; k < 4; ++k) { const int r = rr[k]; if (r0 + k * NGW < M) {
            int keyrow; float *okv, *okr;
            if (r < MP) { keyrow = r; okv = p.out + OUT_KVP + (size_t)r * 128; okr = p.out + OUT_KRP + (size_t)r * 32; }
            else { const int rs_ = r - MP, b = rs_ >> 5, j = rs_ & 31; keyrow = MP + b * LSK + PAST + j; okv = p.out + OUT_KVS + (size_t)rs_ * 128; okr = p.out + OUT_KRS + (size_t)rs_ * 32; }
            const float rs = __builtin_amdgcn_rsqf(ss[k] * (1.0f / 128.0f) + EPS);
            const f32x4 vn = v[k] * gkv * rs;
            if (lane < 32) { *(f32x4*)(okv + 4 * lane) = vn; st_bf4(CKV + (size_t)keyrow * 128 + 4 * lane, vn); }
            if (lane < 16) { const float o1 = x1[k] * cs[k].x - x2[k] * cs[k].y, o2 = x2[k] * cs[k].x + x1[k] * cs[k].y; okr[lane] = o1; okr[16 + lane] = o2;
                KPE[(size_t)keyrow * 32 + lane] = (bf16_t)(pk2(o1, 0.f) & 0xffffu); KPE[(size_t)keyrow * 32 + 16 + lane] = (bf16_t)(pk2(o2, 0.f) & 0xffffu); }
            if (lane == 0) RQ[r] = __builtin_amdgcn_rsqf(sq[k] * (1.0f / 384.0f) + EPS); } }
    }
    for (int c0_ = gw; c0_ < NB * PAST; c0_ += 4 * NGW) {
        f32x4 a[4], c[4];
#pragma unroll
        for (int k = 0; k < 4; ++k) { const int cr = c0_ + k * NGW < NB * PAST ? c0_ + k * NGW : c0_; a[k] = (f32x4){0.f, 0.f, 0.f, 0.f}; c[k] = a[k];
            if (lane < 32) a[k] = *(const f32x4*)(p.in[I_CKV] + (size_t)cr * 128 + 4 * lane);
            if (lane < 8) c[k] = *(const f32x4*)(p.in[I_CKR] + (size_t)cr * 32 + 4 * lane); }
#pragma unroll
        for (int k = 0; k < 4; ++k) { const int cr = c0_ + k * NGW; if (cr < NB * PAST) { const int b = cr >> 11, j = cr & 2047, keyrow = MP + b * LSK + j;
            if (lane < 32) st_bf4(CKV + (size_t)keyrow * 128 + 4 * lane, a[k]);
            if (lane < 8) st_bf4(KPE + (size_t)keyrow * 32 + 4 * lane, c[k]); } }
    }
    {
        bf16_t* BG = (bf16_t*)(ws + OFF_BG); const bf16_t* CIN = (const bf16_t*)(ws + OFF_CIN);
        const int gt = blockIdx.x * 512 + threadIdx.x, NT = gridDim.x * 512, c8 = gt & 127, c0 = c8 * 8;
        float w0[8], w1[8], w2[8];
#pragma unroll
        for (int j = 0; j < 8; ++j) { w0[j] = p.in[I_CONVW][c0 + j]; w1[j] = p.in[I_CONVW][1024 + c0 + j]; w2[j] = p.in[I_CONVW][2048 + c0 + j]; }
        const int nchunk = NT >> 7, RC = (M + nchunk - 1) / nchunk, rbeg = (gt >> 7) * RC, rend = rbeg + RC < M ? rbeg + RC : M;
#define CV_UNPK(dst, ZV) do { const u32x4 zv_ = (ZV); dst[0] = bflo(zv_.x); dst[1] = bfhi(zv_.x); dst[2] = bflo(zv_.y); dst[3] = bfhi(zv_.y); dst[4] = bflo(zv_.z); dst[5] = bfhi(zv_.z); dst[6] = bflo(zv_.w); dst[7] = bfhi(zv_.w); } while (0)
        float xm1[8], xm2[8];
#pragma unroll
        for (int j = 0; j < 8; ++j) { xm1[j] = 0.f; xm2[j] = 0.f; }
        if (rbeg < rend) {
            if (rbeg >= 1) { const u32x4 z = *(const u32x4*)(CIN + (size_t)(rbeg - 1) * 1024 + c0); CV_UNPK(xm1, z); }
            if (rbeg >= 2) { const u32x4 z = *(const u32x4*)(CIN + (size_t)(rbeg - 2) * 1024 + c0); CV_UNPK(xm2, z); }
        }
        for (int r4 = rbeg; r4 < rend; r4 += 4) {
            u32x4 cz[4], bz[4];
#pragma unroll
            for (int k = 0; k < 4; ++k) { const int r = r4 + k < rend ? r4 + k : rend - 1; cz[k] = *(const u32x4*)(CIN + (size_t)r * 1024 + c0); bz[k] = *(const u32x4*)(BG + (size_t)r * 1024 + c0); }
#pragma unroll
            for (int k = 0; k < 4; ++k) { const int r = r4 + k; if (r < rend) {
                float x0[8], bg[8]; CV_UNPK(x0, cz[k]); CV_UNPK(bg, bz[k]);
                int i, bb; const bool prompt = r < MP;
                if (prompt) { bb = r / LP; i = r - bb * LP; } else { bb = (r - MP) >> 5; i = (r - MP) & 31; }
                if (i == 0) {
#pragma unroll
                    for (int j = 0; j < 8; ++j) { xm1[j] = prompt ? 0.f : p.in[I_CCONV][((size_t)bb * 2 + 1) * 1024 + c0 + j]; xm2[j] = prompt ? 0.f : p.in[I_CCONV][((size_t)bb * 2) * 1024 + c0 + j]; } }
                else if (i == 1) {
#pragma unroll
                    for (int j = 0; j < 8; ++j) xm2[j] = prompt ? 0.f : p.in[I_CCONV][((size_t)bb * 2 + 1) * 1024 + c0 + j]; }
                float o[8];
#pragma unroll
                for (int j = 0; j < 8; ++j) o[j] = bg[j] * (w0[j] * xm2[j] + w1[j] * xm1[j] + w2[j] * x0[j]);
                u32x4 w; w.x = pk2(o[0], o[1]); w.y = pk2(o[2], o[3]); w.z = pk2(o[4], o[5]); w.w = pk2(o[6], o[7]);
                *(u32x4*)(BG + (size_t)r * 1024 + c0) = w;
                const int L = prompt ? LP : DS;
                if (i >= L - 2) { float* op = p.out + (prompt ? OUT_NCP : OUT_NCS) + ((size_t)bb * 2 + (i - (L - 2))) * 1024 + c0;
                    *(f32x4*)op = (f32x4){x0[0], x0[1], x0[2], x0[3]}; *(f32x4*)(op + 4) = (f32x4){x0[4], x0[5], x0[6], x0[7]}; }
#pragma unroll
                for (int j = 0; j < 8; ++j) { xm2[j] = xm1[j]; xm1[j] = x0[j]; } } }
        }
#undef CV_UNPK
    }
}

#define MFMA32(a, b, c) __builtin_amdgcn_mfma_f32_32x32x16_bf16((a), (b), (c), 0, 0, 0)
constexpr int KROW_B = 208, VROW_B = 136, KBUF_B = 64 * KROW_B, VBUF_B = 64 * VROW_B, ABUF_B = KBUF_B + VBUF_B;
template <bool FAST> DI void attn_body(const Params& p, LAS unsigned char* lds, int hh, float m0) {
    unsigned char* ws = p.ws;
    const int tid = threadIdx.x, wid = __builtin_amdgcn_readfirstlane(tid >> 6), lane = tid & 63, q = lane & 31, hl = lane >> 5;
    const bf16_t* QR = (const bf16_t*)(ws + OFF_QR); const bf16_t* KH = (const bf16_t*)(ws + OFF_KH); const bf16_t* VT = (const bf16_t*)(ws + OFF_VT);
    bf16_t* ATT = (bf16_t*)(ws + OFF_ATT); const f32x2* rot = (const f32x2*)(ws + OFF_ROT); const float* qg = p.in[I_QN];
    const int kp_row = tid / 12, kp_c = tid - kp_row * 12, kp2 = 512 + tid, kp2_row = kp2 / 12, kp2_c = kp2 - kp2_row * 12;
    const int v_row = tid >> 3, v_c = tid & 7;
    const int vbk = (int)*(volatile LAS unsigned*)(lds + 131072 + 8);
    for (int ii = 0; ii < 9; ++ii) {
        int b, h, kb, vt0, ntile, qrow = -1, nvalid = 0, nk = 0, pos0 = 0, kind, g = 0, idx;
        { const int x = vbk & 7, r = vbk >> 3, grp = r >> 3, j = r & 7;
          if (ii < 8) { kind = 0; idx = x * 16 + (ii >> 1) * 4 + grp; g = (ii & 1) ? j : 15 - j; }
          else if (r < 16) { kind = 1; idx = x * 16 + r; }
          else { kind = 2; idx = x * 16 + (r - 16); } }
        b = idx >> 3; h = idx & 7;
        if (kind == 0) { const int c = 4 * g + (wid >> 1), i0 = 16 + 64 * c + 32 * (wid & 1); qrow = b * LP + i0; nvalid = 32; nk = 64 * c + 80; pos0 = i0; kb = b * LP; vt0 = b * 65; ntile = 4 * g + 5; }
        else if (kind == 1) { kb = MP + b * LSK; vt0 = 16 * 65 + b * 33; ntile = 33;
            if (wid == 0) { qrow = MP + b * DS; nvalid = 32; nk = LSK; pos0 = 16 + PAST; } }
        else { kb = b * LP; vt0 = b * 65; ntile = 1;
            if (wid == 0) { qrow = b * LP; nvalid = 16; nk = 16; pos0 = 0; } }
        const int hg = 8 * hh + h, ntw = (nk + 63) >> 6;
        bf16x8 qf[6];
#pragma unroll
        for (int s = 0; s < 6; ++s) qf[s] = (bf16x8){0, 0, 0, 0, 0, 0, 0, 0};
        if (qrow >= 0) {
            const bf16_t* qp = QR + (size_t)(qrow + q) * 1536 + hg * 96 + 8 * hl;
            float x[6][8]; float ss = 0.f;
#pragma unroll
            for (int s = 0; s < 6; ++s) { const u32x4 z = *(const u32x4*)(qp + 16 * s);
                x[s][0] = bflo(z.x); x[s][1] = bfhi(z.x); x[s][2] = bflo(z.y); x[s][3] = bfhi(z.y); x[s][4] = bflo(z.z); x[s][5] = bfhi(z.z); x[s][6] = bflo(z.w); x[s][7] = bfhi(z.w);
#pragma unroll
                for (int e = 0; e < 8; ++e) ss += x[s][e] * x[s][e]; }
            ss += __shfl_xor(ss, 32);
            const float rs = __builtin_amdgcn_rsqf(ss * (1.0f / 96.0f) + EPS) * (0.10206207261596575f * 1.4426950408889634f);
            const f32x2* rp = rot + (size_t)(pos0 + q) * 16 + 8 * hl;
#pragma unroll
            for (int e = 0; e < 8; ++e) { const f32x2 cs = rp[e]; const float a = x[4][e], bb = x[5][e]; x[4][e] = a * cs.x - bb * cs.y; x[5][e] = bb * cs.x + a * cs.y; }
#pragma unroll
            for (int s = 0; s < 6; ++s) { const f32x4 g0 = *(const f32x4*)(qg + 16 * s + 8 * hl), g1 = *(const f32x4*)(qg + 16 * s + 8 * hl + 4);
                u32x4 w; w.x = pk2(x[s][0] * g0[0] * rs, x[s][1] * g0[1] * rs); w.y = pk2(x[s][2] * g0[2] * rs, x[s][3] * g0[3] * rs);
                w.z = pk2(x[s][4] * g1[0] * rs, x[s][5] * g1[1] * rs); w.w = pk2(x[s][6] * g1[2] * rs, x[s][7] * g1[3] * rs);
                qf[s] = __builtin_bit_cast(bf16x8, w); }
        }
        const bf16_t* kbase = KH + ((size_t)h * MKP + kb) * 96 + tid * 8;
        const bf16_t* vbase = VT + (((size_t)h * NVT + vt0) << 12) + tid * 8;
        u32x4 kr0, kr1 = (u32x4){0, 0, 0, 0}, vr;
        kr0 = *(const u32x4*)(kbase);
        if (tid < 256) kr1 = *(const u32x4*)(kbase + 4096);
        vr = *(const u32x4*)(vbase);
        *(LAS u32x4*)(lds + kp_row * KROW_B + kp_c * 16) = kr0;
        if (tid < 256) *(LAS u32x4*)(lds + kp2_row * KROW_B + kp2_c * 16) = kr1;
        *(LAS u32x2*)(lds + KBUF_B + v_row * VROW_B + v_c * 16) = (u32x2){vr.x, vr.y}; *(LAS u32x2*)(lds + KBUF_B + v_row * VROW_B + v_c * 16 + 8) = (u32x2){vr.z, vr.w};
        __syncthreads();
        float mrun = -1e30f, lrun = 0.f;
        f32x16 o0, o1;
#pragma unroll
        for (int i = 0; i < 16; ++i) { o0[i] = 0.f; o1[i] = 0.f; }
        for (int t = 0; t < ntile; ++t) {
            const bool more = (t + 1 < ntile);
            if (more) { const size_t ko = (size_t)(t + 1) * 6144;
                kr0 = *(const u32x4*)(kbase + ko);
                if (tid < 256) kr1 = *(const u32x4*)(kbase + ko + 4096);
                vr = *(const u32x4*)(vbase + (size_t)(t + 1) * 4096); }
            if (t < ntw) {
                const LAS unsigned char* Kb = lds + (t & 1) * ABUF_B; const LAS unsigned char* Vb = Kb + KBUF_B;
                f32x16 s0, s1;
#pragma unroll
                for (int i = 0; i < 16; ++i) { s0[i] = FAST ? -m0 : 0.f; s1[i] = FAST ? -m0 : 0.f; }
#pragma unroll
                for (int s = 0; s < 6; ++s) {
                    const bf16x8 k0 = *(const LAS bf16x8*)(Kb + q * KROW_B + s * 32 + hl * 16);
                    const bf16x8 k1 = *(const LAS bf16x8*)(Kb + (q + 32) * KROW_B + s * 32 + hl * 16);
                    s0 = MFMA32(k0, qf[s], s0); s1 = MFMA32(k1, qf[s], s1);
                }
                if (64 * (t + 1) > nk) {
#pragma unroll
                    for (int i = 0; i < 16; ++i) { const int key = 64 * t + (i & 3) + 8 * (i >> 2) + 4 * hl; if (key >= nk) s0[i] = -1e30f; if (key + 32 >= nk) s1[i] = -1e30f; }
                }
                float ps = 0.f;
                if (FAST) {
#pragma unroll
                    for (int i = 0; i < 16; ++i) { s0[i] = __builtin_amdgcn_exp2f(s0[i]); s1[i] = __builtin_amdgcn_exp2f(s1[i]); ps += s0[i] + s1[i]; }
                    lrun += ps;
                } else {
                    float mx = fmaxf(s0[0], s1[0]);
#pragma unroll
                    for (int i = 1; i < 16; ++i) mx = fmaxf(mx, fmaxf(s0[i], s1[i]));
                    mx = fmaxf(mx, __shfl_xor(mx, 32));
                    const float mn = fmaxf(mrun, mx), alpha = __builtin_amdgcn_exp2f(mrun - mn); mrun = mn;
#pragma unroll
                    for (int i = 0; i < 16; ++i) { s0[i] = __builtin_amdgcn_exp2f(s0[i] - mn); s1[i] = __builtin_amdgcn_exp2f(s1[i] - mn); ps += s0[i] + s1[i]; }
                    lrun = lrun * alpha + ps;
#pragma unroll
                    for (int i = 0; i < 16; ++i) { o0[i] *= alpha; o1[i] *= alpha; }
                }
#pragma unroll
                for (int kb2 = 0; kb2 < 2; ++kb2)
#pragma unroll
                    for (int s2 = 0; s2 < 2; ++s2) {
                        u32x4 pw;
                        if (kb2 == 0) { pw.x = pk2(s0[8 * s2 + 0], s0[8 * s2 + 1]); pw.y = pk2(s0[8 * s2 + 2], s0[8 * s2 + 3]); pw.z = pk2(s0[8 * s2 + 4], s0[8 * s2 + 5]); pw.w = pk2(s0[8 * s2 + 6], s0[8 * s2 + 7]); }
                        else { pw.x = pk2(s1[8 * s2 + 0], s1[8 * s2 + 1]); pw.y = pk2(s1[8 * s2 + 2], s1[8 * s2 + 3]); pw.z = pk2(s1[8 * s2 + 4], s1[8 * s2 + 5]); pw.w = pk2(s1[8 * s2 + 6], s1[8 * s2 + 7]); }
                        const bf16x8 pf = __builtin_bit_cast(bf16x8, pw);
                        const int kofs = (32 * kb2 + 16 * s2 + 4 * hl) * 2;
                        const u32x2 a0 = *(const LAS u32x2*)(Vb + q * VROW_B + kofs), a1 = *(const LAS u32x2*)(Vb + q * VROW_B + kofs + 16);
                        const u32x2 c0 = *(const LAS u32x2*)(Vb + (q + 32) * VROW_B + kofs), c1 = *(const LAS u32x2*)(Vb + (q + 32) * VROW_B + kofs + 16);
                        o0 = MFMA32(__builtin_bit_cast(bf16x8, ((u32x4){a0.x, a0.y, a1.x, a1.y})), pf, o0);
                        o1 = MFMA32(__builtin_bit_cast(bf16x8, ((u32x4){c0.x, c0.y, c1.x, c1.y})), pf, o1);
                    }
            }
            if (more) { LAS unsigned char* nb = lds + ((t + 1) & 1) * ABUF_B;
                *(LAS u32x4*)(nb + kp_row * KROW_B + kp_c * 16) = kr0;
                if (tid < 256) *(LAS u32x4*)(nb + kp2_row * KROW_B + kp2_c * 16) = kr1;
                *(LAS u32x2*)(nb + KBUF_B + v_row * VROW_B + v_c * 16) = (u32x2){vr.x, vr.y}; *(LAS u32x2*)(nb + KBUF_B + v_row * VROW_B + v_c * 16 + 8) = (u32x2){vr.z, vr.w}; }
            __syncthreads();
        }
        if (qrow >= 0) {
            const float inv = 1.0f / (lrun + __shfl_xor(lrun, 32));
            if (q < nvalid) { bf16_t* op = ATT + (size_t)(qrow + q) * 1024 + hg * 64 + 4 * hl;
#pragma unroll
                for (int ig = 0; ig < 4; ++ig) {
                    st_bf4(op + 8 * ig, (f32x4){o0[4 * ig] * inv, o0[4 * ig + 1] * inv, o0[4 * ig + 2] * inv, o0[4 * ig + 3] * inv});
                    st_bf4(op + 32 + 8 * ig, (f32x4){o1[4 * ig] * inv, o1[4 * ig + 1] * inv, o1[4 * ig + 2] * inv, o1[4 * ig + 3] * inv}); } }
        }
    }
}
DI void load_q(const bf16_t* QR, const f32x2* rot, const float* qg, int qrow, int hg, int pos0, int q, int hl, bf16x8 (&qf)[6]) {
    const bf16_t* qp = QR + (size_t)(qrow + q) * 1536 + hg * 96 + 8 * hl;
    float x[6][8]; float ss = 0.f;
#pragma unroll
    for (int s = 0; s < 6; ++s) { const u32x4 z = *(const u32x4*)(qp + 16 * s);
        x[s][0] = bflo(z.x); x[s][1] = bfhi(z.x); x[s][2] = bflo(z.y); x[s][3] = bfhi(z.y); x[s][4] = bflo(z.z); x[s][5] = bfhi(z.z); x[s][6] = bflo(z.w); x[s][7] = bfhi(z.w);
#pragma unroll
        for (int e = 0; e < 8; ++e) ss += x[s][e] * x[s][e]; }
    ss += __shfl_xor(ss, 32);
    const float rs = __builtin_amdgcn_rsqf(ss * (1.0f / 96.0f) + EPS) * (0.10206207261596575f * 1.4426950408889634f);
    const f32x2* rp = rot + (size_t)(pos0 + q) * 16 + 8 * hl;
#pragma unroll
    for (int e = 0; e < 8; ++e) { const f32x2 cs = rp[e]; const float a = x[4][e], bb = x[5][e]; x[4][e] = a * cs.x - bb * cs.y; x[5][e] = bb * cs.x + a * cs.y; }
#pragma unroll
    for (int s = 0; s < 6; ++s) { const f32x4 g0 = *(const f32x4*)(qg + 16 * s + 8 * hl), g1 = *(const f32x4*)(qg + 16 * s + 8 * hl + 4);
        u32x4 w; w.x = pk2(x[s][0] * g0[0] * rs, x[s][1] * g0[1] * rs); w.y = pk2(x[s][2] * g0[2] * rs, x[s][3] * g0[3] * rs);
        w.z = pk2(x[s][4] * g1[0] * rs, x[s][5] * g1[1] * rs); w.w = pk2(x[s][6] * g1[2] * rs, x[s][7] * g1[3] * rs);
        qf[s] = __builtin_bit_cast(bf16x8, w); }
}
DI void attn_sample(const Params& p, LAS unsigned char* lds, int hh, float m0, int b, int h) {
    unsigned char* ws = p.ws;
    const int tid = threadIdx.x, wid = __builtin_amdgcn_readfirstlane(tid >> 6), lane = tid & 63, q = lane & 31, hl = lane >> 5;
    const bf16_t* KH = (const bf16_t*)(ws + OFF_KH); const bf16_t* VT = (const bf16_t*)(ws + OFF_VT); bf16_t* ATT = (bf16_t*)(ws + OFF_ATT);
    const int kb = MP + b * LSK, vt0 = 16 * 65 + b * 33, qrow = MP + b * DS, hg = 8 * hh + h, nk = LSK;
    bf16x8 qf[6];
    load_q((const bf16_t*)(ws + OFF_QR), (const f32x2*)(ws + OFF_ROT), p.in[I_QN], qrow, hg, 16 + PAST, q, hl, qf);
    f32x16 c0, c1; float lsum = 0.f;
#pragma unroll
    for (int i = 0; i < 16; ++i) { c0[i] = 0.f; c1[i] = 0.f; }
    for (int t = wid; t < 33; t += 8) {
        const bf16_t* kp = KH + ((size_t)h * MKP + kb + 64 * t + q) * 96 + 8 * hl;
        const bf16_t* vp = VT + (((size_t)h * NVT + vt0 + t) << 12) + q * 64 + 4 * hl;
        f32x16 x0, x1;
#pragma unroll
        for (int i = 0; i < 16; ++i) { x0[i] = -m0; x1[i] = -m0; }
        { bf16x8 k0[6];
#pragma unroll
          for (int s_ = 0; s_ < 6; ++s_) k0[s_] = *(const bf16x8*)(kp + 16 * s_);
#pragma unroll
          for (int s_ = 0; s_ < 6; ++s_) x0 = MFMA32(k0[s_], qf[s_], x0); }
        { bf16x8 k1[6];
#pragma unroll
          for (int s_ = 0; s_ < 6; ++s_) k1[s_] = *(const bf16x8*)(kp + 32 * 96 + 16 * s_);
#pragma unroll
          for (int s_ = 0; s_ < 6; ++s_) x1 = MFMA32(k1[s_], qf[s_], x1); }
        u32x2 va[4][2], vc[4][2];
#pragma unroll
        for (int f_ = 0; f_ < 4; ++f_) { va[f_][0] = *(const u32x2*)(vp + 16 * f_); va[f_][1] = *(const u32x2*)(vp + 16 * f_ + 8);
            vc[f_][0] = *(const u32x2*)(vp + 32 * 64 + 16 * f_); vc[f_][1] = *(const u32x2*)(vp + 32 * 64 + 16 * f_ + 8); }
        if (64 * (t + 1) > nk) {
#pragma unroll
            for (int i = 0; i < 16; ++i) { const int key = 64 * t + (i & 3) + 8 * (i >> 2) + 4 * hl; if (key >= nk) x0[i] = -1e30f; if (key + 32 >= nk) x1[i] = -1e30f; } }
        float ps = 0.f;
#pragma unroll
        for (int i = 0; i < 16; ++i) { x0[i] = __builtin_amdgcn_exp2f(x0[i]); x1[i] = __builtin_amdgcn_exp2f(x1[i]); ps += x0[i] + x1[i]; }
        lsum += ps;
#pragma unroll
        for (int s2 = 0; s2 < 2; ++s2) { u32x4 pw;
            pw.x = pk2(x0[8 * s2 + 0], x0[8 * s2 + 1]); pw.y = pk2(x0[8 * s2 + 2], x0[8 * s2 + 3]); pw.z = pk2(x0[8 * s2 + 4], x0[8 * s2 + 5]); pw.w = pk2(x0[8 * s2 + 6], x0[8 * s2 + 7]);
            const bf16x8 p0 = __builtin_bit_cast(bf16x8, pw);
            pw.x = pk2(x1[8 * s2 + 0], x1[8 * s2 + 1]); pw.y = pk2(x1[8 * s2 + 2], x1[8 * s2 + 3]); pw.z = pk2(x1[8 * s2 + 4], x1[8 * s2 + 5]); pw.w = pk2(x1[8 * s2 + 6], x1[8 * s2 + 7]);
            const bf16x8 p1 = __builtin_bit_cast(bf16x8, pw);
            c0 = MFMA32(__builtin_bit_cast(bf16x8, ((u32x4){va[s2][0].x, va[s2][0].y, va[s2][1].x, va[s2][1].y})), p0, c0);
            c1 = MFMA32(__builtin_bit_cast(bf16x8, ((u32x4){vc[s2][0].x, vc[s2][0].y, vc[s2][1].x, vc[s2][1].y})), p0, c1);
            c0 = MFMA32(__builtin_bit_cast(bf16x8, ((u32x4){va[2 + s2][0].x, va[2 + s2][0].y, va[2 + s2][1].x, va[2 + s2][1].y})), p1, c0);
            c1 = MFMA32(__builtin_bit_cast(bf16x8, ((u32x4){vc[2 + s2][0].x, vc[2 + s2][0].y, vc[2 + s2][1].x, vc[2 + s2][1].y})), p1, c1); }
    }
    LAS float* red = (LAS float*)lds;
#pragma unroll
    for (int i = 0; i < 16; ++i) { red[(wid * 33 + i) * 64 + lane] = c0[i]; red[(wid * 33 + 16 + i) * 64 + lane] = c1[i]; }
    red[(wid * 33 + 32) * 64 + lane] = lsum;
    asm volatile("s_waitcnt lgkmcnt(0)" ::: "memory"); __builtin_amdgcn_s_barrier(); asm volatile("" ::: "memory");
    if (wid == 0) {
#pragma unroll 1
        for (int w = 1; w < 8; ++w) {
#pragma unroll
            for (int i = 0; i < 16; ++i) { c0[i] += red[(w * 33 + i) * 64 + lane]; c1[i] += red[(w * 33 + 16 + i) * 64 + lane]; }
            lsum += red[(w * 33 + 32) * 64 + lane]; }
        const float inv = 1.0f / (lsum + __shfl_xor(lsum, 32));
        bf16_t* op = ATT + (size_t)(qrow + q) * 1024 + hg * 64 + 4 * hl;
#pragma unroll
        for (int ig = 0; ig < 4; ++ig) {
            st_bf4(op + 8 * ig, (f32x4){c0[4 * ig] * inv, c0[4 * ig + 1] * inv, c0[4 * ig + 2] * inv, c0[4 * ig + 3] * inv});
            st_bf4(op + 32 + 8 * ig, (f32x4){c1[4 * ig] * inv, c1[4 * ig + 1] * inv, c1[4 * ig + 2] * inv, c1[4 * ig + 3] * inv}); }
    }
    asm volatile("s_waitcnt lgkmcnt(0)" ::: "memory"); __builtin_amdgcn_s_barrier(); asm volatile("" ::: "memory");
}
DI void attn_pp(const Params& p, LAS unsigned char* lds, int hh, float m0) {
    unsigned char* ws = p.ws;
    const int tid = threadIdx.x, wid = __builtin_amdgcn_readfirstlane(tid >> 6), lane = tid & 63, q = lane & 31, hl = lane >> 5;
    const bool grpB = wid >= 4;
    const bf16_t* QR = (const bf16_t*)(ws + OFF_QR); const bf16_t* KH = (const bf16_t*)(ws + OFF_KH); const bf16_t* VT = (const bf16_t*)(ws + OFF_VT);
    bf16_t* ATT = (bf16_t*)(ws + OFF_ATT); const f32x2* rot = (const f32x2*)(ws + OFF_ROT); const float* qg = p.in[I_QN];
    const int kp_row = tid / 12, kp_c = tid - kp_row * 12, kp2 = 512 + tid, kp2_row = kp2 / 12, kp2_c = kp2 - kp2_row * 12;
    const int v_row = tid >> 3, v_c = tid & 7;
#define APP_BAR() do { asm volatile("s_waitcnt lgkmcnt(0)" ::: "memory"); __builtin_amdgcn_s_barrier(); asm volatile("" ::: "memory"); } while (0)
    const int vbk = (int)*(volatile LAS unsigned*)(lds + 131072 + 8);
    for (int ii = 0; ii < 9; ++ii) {
        int b, h, kb, vt0, ntile, qrow = -1, nvalid = 0, nk = 0, pos0 = 0, kind, g = 0, idx;
        { const int x = vbk & 7, r = vbk >> 3, grp = r >> 3, j = r & 7;
          if (ii < 8) { kind = 0; idx = x * 16 + (ii >> 1) * 4 + grp; g = (ii & 1) ? j : 15 - j; }
          else if (r < 16) { kind = 1; idx = x * 16 + r; }
          else { kind = 2; idx = x * 16 + (r - 16); } }
        if (kind == 1) { attn_sample(p, lds, hh, m0, idx >> 3, idx & 7); continue; }
        b = idx >> 3; h = idx & 7;
        if (kind == 0) { const int c = 4 * g + (wid >> 1), i0 = 16 + 64 * c + 32 * (wid & 1); qrow = b * LP + i0; nvalid = 32; nk = 64 * c + 80; pos0 = i0; kb = b * LP; vt0 = b * 65; ntile = 4 * g + 5; }
        else if (kind == 1) { kb = MP + b * LSK; vt0 = 16 * 65 + b * 33; ntile = 33;
            if (wid == 0) { qrow = MP + b * DS; nvalid = 32; nk = LSK; pos0 = 16 + PAST; } }
        else { kb = b * LP; vt0 = b * 65; ntile = 1;
            if (wid == 0) { qrow = b * LP; nvalid = 16; nk = 16; pos0 = 0; } }
        const int hg = 8 * hh + h, ntw = qrow >= 0 ? (nk + 63) >> 6 : 0;
        const bf16_t* kbase = KH + ((size_t)h * MKP + kb) * 96 + tid * 8;
        const bf16_t* vbase = VT + (((size_t)h * NVT + vt0) << 12) + tid * 8;
        u32x4 ka0 = (u32x4){0, 0, 0, 0}, ka1 = ka0, va = ka0, kb0 = ka0, kb1 = ka0, vb = ka0;
#define APP_LOAD(K0, K1, V, tK, tV) do { if ((tK) < ntile) { const size_t ko_ = (size_t)(tK) * 6144; K0 = *(const u32x4*)(kbase + ko_); \
            if (tid < 256) K1 = *(const u32x4*)(kbase + ko_ + 4096); } if ((tV) < ntile) V = *(const u32x4*)(vbase + (size_t)(tV) * 4096); } while (0)
#define APP_WRITE(K0, K1, V, tK, tV) do { if ((tK) < ntile) { LAS unsigned char* kd_ = lds + ((tK) & 1) * ABUF_B; *(LAS u32x4*)(kd_ + kp_row * KROW_B + kp_c * 16) = K0; \
            if (tid < 256) *(LAS u32x4*)(kd_ + kp2_row * KROW_B + kp2_c * 16) = K1; } \
            if ((tV) < ntile) { LAS unsigned char* vd_ = lds + ((tV) & 1) * ABUF_B + KBUF_B + v_row * VROW_B + v_c * 16; *(LAS u32x2*)vd_ = (u32x2){V.x, V.y}; *(LAS u32x2*)(vd_ + 8) = (u32x2){V.z, V.w}; } } while (0)
        APP_LOAD(ka0, ka1, va, 0, ntile);
        APP_LOAD(kb0, kb1, vb, 1, 0);
        bf16x8 qf[6];
#pragma unroll
        for (int s = 0; s < 6; ++s) qf[s] = (bf16x8){0, 0, 0, 0, 0, 0, 0, 0};
        if (qrow >= 0) {
            const bf16_t* qp = QR + (size_t)(qrow + q) * 1536 + hg * 96 + 8 * hl;
            float x[6][8]; float ss = 0.f;
#pragma unroll
            for (int s = 0; s < 6; ++s) { const u32x4 z = *(const u32x4*)(qp + 16 * s);
                x[s][0] = bflo(z.x); x[s][1] = bfhi(z.x); x[s][2] = bflo(z.y); x[s][3] = bfhi(z.y); x[s][4] = bflo(z.z); x[s][5] = bfhi(z.z); x[s][6] = bflo(z.w); x[s][7] = bfhi(z.w);
#pragma unroll
                for (int e = 0; e < 8; ++e) ss += x[s][e] * x[s][e]; }
            ss += __shfl_xor(ss, 32);
            const float rs = __builtin_amdgcn_rsqf(ss * (1.0f / 96.0f) + EPS) * (0.10206207261596575f * 1.4426950408889634f);
            const f32x2* rp = rot + (size_t)(pos0 + q) * 16 + 8 * hl;
#pragma unroll
            for (int e = 0; e < 8; ++e) { const f32x2 cs = rp[e]; const float a = x[4][e], bb = x[5][e]; x[4][e] = a * cs.x - bb * cs.y; x[5][e] = bb * cs.x + a * cs.y; }
#pragma unroll
            for (int s = 0; s < 6; ++s) { const f32x4 g0 = *(const f32x4*)(qg + 16 * s + 8 * hl), g1 = *(const f32x4*)(qg + 16 * s + 8 * hl + 4);
                u32x4 w; w.x = pk2(x[s][0] * g0[0] * rs, x[s][1] * g0[1] * rs); w.y = pk2(x[s][2] * g0[2] * rs, x[s][3] * g0[3] * rs);
                w.z = pk2(x[s][4] * g1[0] * rs, x[s][5] * g1[1] * rs); w.w = pk2(x[s][6] * g1[2] * rs, x[s][7] * g1[3] * rs);
                qf[s] = __builtin_bit_cast(bf16x8, w); }
        }
        APP_WRITE(ka0, ka1, va, 0, ntile);
        APP_LOAD(ka0, ka1, va, 2, 1);
        APP_BAR();
        if (grpB) APP_BAR();
        float lrun = 0.f;
        f32x16 o0, o1, s0, s1, cinit;
#pragma unroll
        for (int i = 0; i < 16; ++i) cinit[i] = -m0;
        bf16x8 pf[4];
#pragma unroll
        for (int i = 0; i < 16; ++i) { o0[i] = 0.f; o1[i] = 0.f; s0[i] = 0.f; s1[i] = 0.f; }
#pragma unroll
        for (int i = 0; i < 4; ++i) pf[i] = (bf16x8){0, 0, 0, 0, 0, 0, 0, 0};
#define APP_Z(tt) do { const LAS unsigned char* Vb = lds + ((tt) & 1) * ABUF_B + KBUF_B + q * VROW_B + 8 * hl; \
            u32x2 va_[4][2], vc_[4][2]; \
            _Pragma("unroll") for (int f = 0; f < 4; ++f) { va_[f][0] = *(const LAS u32x2*)(Vb + f * 32); va_[f][1] = *(const LAS u32x2*)(Vb + f * 32 + 16); \
                vc_[f][0] = *(const LAS u32x2*)(Vb + 32 * VROW_B + f * 32); vc_[f][1] = *(const LAS u32x2*)(Vb + 32 * VROW_B + f * 32 + 16); } \
            __builtin_amdgcn_sched_barrier(0); \
            _Pragma("unroll") for (int f = 0; f < 4; ++f) { \
                o0 = MFMA32(__builtin_bit_cast(bf16x8, ((u32x4){va_[f][0].x, va_[f][0].y, va_[f][1].x, va_[f][1].y})), pf[f], o0); \
                o1 = MFMA32(__builtin_bit_cast(bf16x8, ((u32x4){vc_[f][0].x, vc_[f][0].y, vc_[f][1].x, vc_[f][1].y})), pf[f], o1); } } while (0)
#define APP_X(tt) do { const LAS unsigned char* Kb = lds + ((tt) & 1) * ABUF_B + q * KROW_B + hl * 16; \
            { const bf16x8 k0 = *(const LAS bf16x8*)(Kb); const bf16x8 k1 = *(const LAS bf16x8*)(Kb + 32 * KROW_B); \
              s0 = MFMA32(k0, qf[0], cinit); s1 = MFMA32(k1, qf[0], cinit); } \
            _Pragma("unroll") for (int s = 1; s < 6; ++s) { \
                const bf16x8 k0 = *(const LAS bf16x8*)(Kb + s * 32); \
                const bf16x8 k1 = *(const LAS bf16x8*)(Kb + 32 * KROW_B + s * 32); \
                s0 = MFMA32(k0, qf[s], s0); s1 = MFMA32(k1, qf[s], s1); } } while (0)
#define APP_Y(tt) do { if (64 * ((tt) + 1) > nk) { \
                _Pragma("unroll") for (int i = 0; i < 16; ++i) { const int key = 64 * (tt) + (i & 3) + 8 * (i >> 2) + 4 * hl; if (key >= nk) s0[i] = -1e30f; if (key + 32 >= nk) s1[i] = -1e30f; } } \
            float ps = 0.f; \
            _Pragma("unroll") for (int i = 0; i < 16; ++i) { s0[i] = __builtin_amdgcn_exp2f(s0[i]); s1[i] = __builtin_amdgcn_exp2f(s1[i]); ps += s0[i] + s1[i]; } \
            lrun += ps; \
            _Pragma("unroll") for (int s2 = 0; s2 < 2; ++s2) { u32x4 pw; \
                pw.x = pk2(s0[8 * s2 + 0], s0[8 * s2 + 1]); pw.y = pk2(s0[8 * s2 + 2], s0[8 * s2 + 3]); pw.z = pk2(s0[8 * s2 + 4], s0[8 * s2 + 5]); pw.w = pk2(s0[8 * s2 + 6], s0[8 * s2 + 7]); \
                pf[s2] = __builtin_bit_cast(bf16x8, pw); \
                pw.x = pk2(s1[8 * s2 + 0], s1[8 * s2 + 1]); pw.y = pk2(s1[8 * s2 + 2], s1[8 * s2 + 3]); pw.z = pk2(s1[8 * s2 + 4], s1[8 * s2 + 5]); pw.w = pk2(s1[8 * s2 + 6], s1[8 * s2 + 7]); \
                pf[2 + s2] = __builtin_bit_cast(bf16x8, pw); } } while (0)
#define APP_STEP(tt, K0, K1, V) do { \
            if ((tt) > 0 && (tt) - 1 < ntw) APP_Z((tt) - 1); \
            if ((tt) < ntw) APP_X(tt); \
            if (grpB) { APP_WRITE(K0, K1, V, (tt) + 1, (tt)); APP_LOAD(K0, K1, V, (tt) + 3, (tt) + 2); } \
            APP_BAR(); \
            if ((tt) < ntw) APP_Y(tt); \
            if (!grpB) { APP_WRITE(K0, K1, V, (tt) + 1, (tt)); APP_LOAD(K0, K1, V, (tt) + 3, (tt) + 2); } \
            APP_BAR(); } while (0)
        for (int t = 0; t < ntile; t += 2) {
            APP_STEP(t, kb0, kb1, vb);
            if (t + 1 < ntile) APP_STEP(t + 1, ka0, ka1, va);
        }
        if (ntile - 1 < ntw) APP_Z(ntile - 1);
        if (qrow >= 0) {
            const float inv = 1.0f / (lrun + __shfl_xor(lrun, 32));
            if (q < nvalid) { bf16_t* op = ATT + (size_t)(qrow + q) * 1024 + hg * 64 + 4 * hl;
#pragma unroll
                for (int ig = 0; ig < 4; ++ig) {
                    st_bf4(op + 8 * ig, (f32x4){o0[4 * ig] * inv, o0[4 * ig + 1] * inv, o0[4 * ig + 2] * inv, o0[4 * ig + 3] * inv});
                    st_bf4(op + 32 + 8 * ig, (f32x4){o1[4 * ig] * inv, o1[4 * ig + 1] * inv, o1[4 * ig + 2] * inv, o1[4 * ig + 3] * inv}); } }
        }
        if (!grpB) APP_BAR();
    }
#undef APP_BAR
#undef APP_LOAD
#undef APP_WRITE
#undef APP_Z
#undef APP_X
#undef APP_Y
#undef APP_STEP
}
DI void attn_phase(const Params& p, LAS unsigned char* lds, int hh) {
    const int lane = threadIdx.x & 63;
    float mq = fmaxf(fabsf(p.in[I_QN][lane]), lane < 32 ? fabsf(p.in[I_QN][64 + lane]) : 0.f), mk = fmaxf(fabsf(p.in[I_KN][lane]), lane < 32 ? fabsf(p.in[I_KN][64 + lane]) : 0.f);
#pragma unroll
    for (int o = 1; o < 64; o <<= 1) { mq = fmaxf(mq, __shfl_xor(mq, o)); mk = fmaxf(mk, __shfl_xor(mk, o)); }
    const float m0 = 96.0f * 0.10206207261596575f * 1.4426950408889634f * 1.02f * mq * mk;
    if (m0 < 40.0f) attn_pp(p, lds, hh, m0); else attn_body<false>(p, lds, hh, 0.f);
}
DI void kv_half(const Params& p, LAS unsigned char* lds, int hh) {
    unsigned char* ws = p.ws;
    int K128 = 128; asm volatile("" : "+s"(K128));
    EpiK ek{(bf16_t*)(ws + OFF_KH), (const bf16_t*)(ws + OFF_KPE), p.in[I_KN]};
    run_gemm(lds, (const bf16_t*)(ws + OFF_CKV), (const bf16_t*)(ws + OFF_WK) + (size_t)hh * 512 * 128, MK, 512, K128, ek, 0);
    EpiVt ev{(bf16_t*)(ws + OFF_VT)};
    run_gemm(lds, (const bf16_t*)(ws + OFF_WVT) + (size_t)hh * 512 * 128, (const bf16_t*)(ws + OFF_CKV), 512, MK, K128, ev, 6);
}

constexpr int NPHASE = 17;
#ifndef ONLY
#define ONLY -1
#endif
#ifndef REP_PH
#define REP_PH -1
#endif
#ifndef REP_CNT
#define REP_CNT 1
#endif
#define PHASE(n, ...) if ((ONLY < 0 || ONLY == (n)) && p.ph_lo <= (n) && (n) < p.ph_hi) { \
    for (int rep_ = 0; rep_ < ((n) == REP_PH ? REP_CNT : 1); ++rep_) { __VA_ARGS__ if ((n) == REP_PH && rep_ + 1 < REP_CNT) xcd_barrier(xb); } \
    if ((n) + 1 < p.ph_hi) { if (p.ph_hi > 1000) cg::this_grid().sync();   else xcd_barrier(xb); } }
DI void ph_swiglu(const Params& p, LAS unsigned char* lds, size_t woff) {
    EpiSwiglu e{(bf16_t*)(p.ws + OFF_ACT)};
    run_gemm(lds, (const bf16_t*)(p.ws + OFF_H), (const bf16_t*)(p.ws + woff), M, 5632, 1024, e, 0);
}
DI void tail_final(const Params& p) {
    const int lane = threadIdx.x & 63; const float* P = (const float*)(p.ws + OFF_ATT);
    for (int r = M_MAIN + blockIdx.x * 8 + (threadIdx.x >> 6); r < M; r += gridDim.x * 8) { f32x4 t[4]; tail_sum(P, r, 11, lane, t); float* xd = xrow_dst(p, r);
#pragma unroll
        for (int j = 0; j < 4; ++j) { const f32x4 x = *(const f32x4*)(xd + 4 * (lane + 64 * j)); *(f32x4*)(xd + 4 * (lane + 64 * j)) = x + 0.5f * t[j]; } }
}
DI void ph_resid(const Params& p, LAS unsigned char* lds, size_t aoff, size_t woff, int K, int src0, float scale) {
    EpiResid e{p.in[I_XP], p.in[I_META], p.in[I_XS], p.out, (float*)(p.ws + OFF_XM), src0, scale};
    run_gemm(lds, (const bf16_t*)(p.ws + aoff), (const bf16_t*)(p.ws + woff), M_MAIN, 1024, K, e, 0);
    EpiPartial ep{(float*)(p.ws + OFF_ATT)};
    int KS = 256; asm volatile("" : "+s"(KS));
    const int vb = (int)*(volatile LAS unsigned*)(lds + 131072 + 8);
    pg8::Gemm g{(const bf16_t*)(p.ws + aoff), (const bf16_t*)(p.ws + woff), M, 1024, KS, K};
    pg8::TailOrder T; T.pm0 = M_MAIN / 256; T.npm = NTAILP; T.nN = 4; T.S = K / 256; T.G = (int)gridDim.x; T.c = (vb + 100) % (int)gridDim.x;
    pg8::gemm_phase<EpiPartial, pg8::TailOrder>(lds, g, T, ep);
}
__global__ __launch_bounds__(512, 2) void mega(Params p) {
    extern __shared__ __attribute__((aligned(16))) unsigned char shm[];
    LAS unsigned char* lds = (LAS unsigned char*)shm;
    unsigned char* ws = p.ws;
    XcdBarrier xb; xb.bar = (unsigned*)(ws + OFF_BAR); xb.x = xb_xcc_id(); xb.st = (volatile LAS unsigned*)(lds + 131072);
    if (threadIdx.x == 0) { xb.st[0] = 0u; xb.st[1] = 0u; const unsigned rank = xb_add(&xb.bar[XB_XCNT(xb.x)], 1u); xb.st[2] = blockIdx.x; xb.st[3] = rank; }
    __syncthreads();
    PHASE(0, phase_prep(p, lds);)
    if (threadIdx.x == 0) {
        bool even = (gridDim.x % 8u) == 0u;
        for (unsigned j = 0; j < 16; ++j) { const unsigned c = xb_ld(&xb.bar[XB_XCNT(j)]); even = even && (c == (j < 8u ? gridDim.x / 8u : 0u)); }
        if (even && p.ph_lo == 0 && p.ph_hi > 1) xb.st[2] = xb.st[3] * 8u + xb.x;
    }
    __syncthreads();
    PHASE(1, ph_swiglu(p, lds, OFF_W1GU);)
    PHASE(2, ph_resid(p, lds, OFF_ACT, OFF_W1D, 2816, 1, 0.5f);)
    PHASE(3, norm_rows(p, 0, p.in[I_MIXN], (bf16_t*)(ws + OFF_H), 11, 0.5f, 1);)
    PHASE(4, { EpiInProj e{(bf16_t*)(ws + OFF_BG), (bf16_t*)(ws + OFF_CIN), (bf16_t*)(ws + OFF_GC), (bf16_t*)(ws + OFF_GM), (bf16_t*)(ws + OFF_ZQ), (float*)(ws + OFF_ZL)};
            run_gemm(lds, (const bf16_t*)(ws + OFF_H), (const bf16_t*)(ws + OFF_WIN), M, NIN, 1024, e, 0); })
    PHASE(5, phase_lat_conv(p);)
    PHASE(6, { EpiGate e{(bf16_t*)(ws + OFF_H), (const bf16_t*)(ws + OFF_GC), nullptr};
            run_gemm(lds, (const bf16_t*)(ws + OFF_BG), (const bf16_t*)(ws + OFF_WCO), M, 1024, 1024, e, 0); })
    PHASE(7, {  EpiQup e{(bf16_t*)(ws + OFF_QR), (const float*)(ws + OFF_RQ)};
                run_gemm(lds, (const bf16_t*)(ws + OFF_ZQ), (const bf16_t*)(ws + OFF_WUQ), M, 1536, 384, e, 0);
                const int gt = blockIdx.x * 512 + threadIdx.x; const int NT = gridDim.x * 512;
                for (int i = gt; i < 8 * 768; i += NT) *(u32x4*)(ws + OFF_KH + (((size_t)(i / 768) * MKP + MK) * 96) * 2 + (size_t)(i % 768) * 16) = (u32x4){0, 0, 0, 0};
                for (int i = gt; i < 8 * 32 * 64 * 16; i += NT) { const int c4 = i & 15, d = (i >> 4) & 63, sq = (i >> 10) & 31, hh_ = i >> 15;
                    const int tile = sq < 16 ? sq * 65 + 64 : 16 * 65 + (sq - 16) * 33 + 32, j0 = sq < 16 ? 16 : 32;
                    if (c4 * 4 >= j0) *(u32x2*)(ws + OFF_VT + (((((size_t)hh_ * NVT + tile) * 64 + d) << 6) + c4 * 4) * 2) = (u32x2){0, 0}; }
                kv_half(p, lds, 0); })
    PHASE(8, attn_phase(p, lds, 0);)
    PHASE(9, kv_half(p, lds, 1);)
    PHASE(10, attn_phase(p, lds, 1);)
    PHASE(11, { EpiGate e{(bf16_t*)(ws + OFF_MG), (const bf16_t*)(ws + OFF_GM), (const bf16_t*)(ws + OFF_H)};
            run_gemm(lds, (const bf16_t*)(ws + OFF_ATT), (const bf16_t*)(ws + OFF_WMO), M, 1024, 1024, e, 0); })
    PHASE(12, ph_resid(p, lds, OFF_MG, OFF_WOUT, 1024, 0, 1.0f);)
    PHASE(13, norm_rows(p, 0, p.in[I_F2N], (bf16_t*)(ws + OFF_H), 4, 1.0f, 0);)
    PHASE(14, ph_swiglu(p, lds, OFF_W2GU);)
    PHASE(15, ph_resid(p, lds, OFF_ACT, OFF_W2D, 2816, 0, 0.5f);)
    PHASE(16, tail_final(p);)
}

constexpr int LDS_BYTES = 131072 + 16;
extern "C" void kernel_launch(void* const* d_in, const int* in_sizes, int n_in, void* d_out, int out_size, void* d_ws, size_t ws_size, hipStream_t stream) {
    static int grid = 0;
    if (grid == 0) {
        if (n_in != 26 || ws_size < WS_END) { fprintf(stderr, "kernel_launch: need 26 inputs and %zu bytes of workspace (got %d, %zu)\n", (size_t)WS_END, n_in, ws_size); grid = -1; return; }
        int dev = 0, cus = 0, per_cu = 0;
        if (hipGetDevice(&dev) != hipSuccess || hipDeviceGetAttribute(&cus, hipDeviceAttributeMultiprocessorCount, dev) != hipSuccess) { grid = -1; return; }
        if (hipFuncSetAttribute((const void*)mega, hipFuncAttributeMaxDynamicSharedMemorySize, LDS_BYTES) != hipSuccess) { fprintf(stderr, "kernel_launch: hipFuncSetAttribute failed\n"); grid = -1; return; }
        if (hipOccupancyMaxActiveBlocksPerMultiprocessor(&per_cu, (const void*)mega, 512, LDS_BYTES) != hipSuccess || per_cu < 1) { fprintf(stderr, "kernel_launch: occupancy query says %d\n", per_cu); per_cu = 1; }
        (void)hipGetLastError();
        if (cus != 256) { fprintf(stderr, "kernel_launch: built for a 256-CU device (got %d)\n", cus); grid = -1; return; }
        grid = 256;
    }
    if (grid < 0) return;
    if (hipMemsetAsync((char*)d_ws + OFF_BAR, 0, XCD_BAR_WORDS * 4, stream) != hipSuccess) { fprintf(stderr, "kernel_launch: memset failed\n"); return; }
    Params p{};
    for (int i = 0; i < 26; ++i) p.in[i] = (const float*)d_in[i];
    p.out = (float*)d_out; p.ws = (unsigned char*)d_ws;
#if N_LAUNCH_MODE == 1
    p.ph_lo = 0; p.ph_hi = NPHASE;
    void* args[] = {&p};
    hipError_t e = hipLaunchCooperativeKernel((const void*)mega, dim3(grid), dim3(512), args, LDS_BYTES, stream);
    if (e != hipSuccess) fprintf(stderr, "cooperative launch failed: %s (grid %d)\n", hipGetErrorString(e), grid);
#else
    for (int ph = 0; ph < NPHASE; ++ph) { p.ph_lo = ph; p.ph_hi = ph + 1; hipLaunchKernelGGL(mega, dim3(grid), dim3(512), LDS_BYTES, stream, p); }
#endif
}
```
